# Optimizing an MI355X kernel written in HIP

```python
import math
import jax, jax.numpy as jnp
from jax import lax
import numpy as np

D_MODEL = 1024
BATCH = 8
SEQ = 2048
DEPTH = 1

GRID_W = 64
CTX_LEN = 256
CONV_WIDTH = D_MODEL
CONV_K = 3
N_HEADS = 8
HEAD_DIM = 64
V_DIM = 2 * HEAD_DIM
ATTN_QK = N_HEADS * 2 * HEAD_DIM
ATTN_V = N_HEADS * V_DIM
N_EXPERTS = 16
EXPERT_HIDDEN = 2048
CAPACITY_FACTOR = 2
ROPE_THETA = 10000.0
Q_BLOCK = 128
EPS = 1e-6
PROJ_SIZES = (CONV_WIDTH, CONV_WIDTH, CONV_WIDTH, ATTN_QK, ATTN_QK, ATTN_V, D_MODEL, D_MODEL)
PROJ_COLS = sum(PROJ_SIZES)

kernel_name = 'hybrid_conv_diffattn_ec_moe_dit'


def rmsnorm(x, g):
    xf = x.astype(jnp.float32)
    y = xf * lax.rsqrt(jnp.mean(xf * xf, axis=-1, keepdims=True) + EPS)
    return (y * g.astype(jnp.float32)).astype(x.dtype)


def ada_mod(cond, w_ada, b_ada):
    m = jax.nn.silu(cond) @ w_ada + b_ada
    m = m.reshape(-1, 1, 6 * D_MODEL)
    return jnp.split(m, 6, axis=-1)


def modulate(h, shift, scale):
    return h * (1 + scale) + shift


def axial_rope_tables(n):
    rows = n // GRID_W
    row = jnp.repeat(jnp.arange(rows), GRID_W).astype(jnp.float32)
    col = jnp.tile(jnp.arange(GRID_W), rows).astype(jnp.float32)
    per_axis = HEAD_DIM // 2
    inv = ROPE_THETA ** (-jnp.arange(0, per_axis, 2, dtype=jnp.float32) / per_axis)
    ang = jnp.stack([row[:, None] * inv, col[:, None] * inv], axis=1)
    return jnp.cos(ang), jnp.sin(ang)


def apply_rope(x, cos, sin):
    shp = x.shape
    xr = x.astype(jnp.float32).reshape(shp[:-1] + (2, 2, HEAD_DIM // 4))
    x1, x2 = xr[..., 0, :], xr[..., 1, :]
    cs, sn = cos[:, None, None], sin[:, None, None]
    out = jnp.stack([x1 * cs - x2 * sn, x2 * cs + x1 * sn], axis=-2)
    return out.reshape(shp).astype(x.dtype)


def split_proj(p):
    idx = [int(v) for v in np.cumsum(PROJ_SIZES)[:-1]]
    return jnp.split(p, idx, axis=-1)


def attn_heads(parts):
    B, n, _ = parts[3].shape
    q = parts[3].reshape(B, n, N_HEADS, 2, HEAD_DIM)
    k = parts[4].reshape(B, n, N_HEADS, 2, HEAD_DIM)
    v = parts[5].reshape(B, n, N_HEADS, V_DIM).transpose(0, 2, 1, 3)
    return q, k, v


def to_bhm(t):
    return t.transpose(0, 2, 3, 1, 4)


def diff_attn(q, k, v, lam):
    s = jnp.einsum('bhmqd,bhmkd->bhmqk', q, k).astype(jnp.float32) * (HEAD_DIM ** -0.5)
    p = jax.nn.softmax(s, axis=-1)
    a = p[:, :, 0] - lam * p[:, :, 1]
    return jnp.einsum('bhqk,bhkv->bhqv', a.astype(v.dtype), v)


def blocked_diff_attn(q, k, v, lam):
    B, H, _, n, hd = q.shape
    nb = n // Q_BLOCK
    qb = q.reshape(B, H, 2, nb, Q_BLOCK, hd).transpose(3, 0, 1, 2, 4, 5)
    ob = lax.map(lambda qi: diff_attn(qi, k, v, lam), qb)
    return ob.transpose(1, 2, 0, 3, 4).reshape(B, H, n, V_DIM)


def short_conv_branch(u, gate_b, gate_c, conv_w, w_out_conv):
    z = gate_c * u
    zp = jnp.pad(z, ((0, 0), (1, 1), (0, 0)))
    y = zp[:, :-2] * conv_w[0] + zp[:, 1:-1] * conv_w[1] + zp[:, 2:] * conv_w[2]
    return (gate_b * y) @ w_out_conv


def merge_branches(parts, o, conv_w, w_out_conv, subln_g, lam_init, w_o_attn, w_out):
    y_conv = short_conv_branch(parts[0], parts[1], parts[2], conv_w, w_out_conv)
    B, H, n, _ = o.shape
    o = rmsnorm(o, subln_g) * (1.0 - lam_init)
    y_attn = o.transpose(0, 2, 1, 3).reshape(B, n, ATTN_V) @ w_o_attn
    merged = jax.nn.sigmoid(parts[6]) * y_conv + jax.nn.sigmoid(parts[7]) * y_attn
    return merged @ w_out


def expert_choice_ffn(h, w_router, w_gate, w_up, w_down):
    B, n, _ = h.shape
    cap = CAPACITY_FACTOR * n // N_EXPERTS
    aff = jax.nn.softmax((h @ w_router).astype(jnp.float32), axis=-1)
    g, idx = lax.top_k(aff.transpose(0, 2, 1), cap)
    bidx = jnp.arange(B)[:, None, None]
    xs = h[bidx, idx]
    a = jnp.einsum('becd,edf->becf', xs, w_gate)
    u = jnp.einsum('becd,edf->becf', xs, w_up)
    y = jnp.einsum('becf,efd->becd', jax.nn.silu(a) * u, w_down)
    y = y * g[..., None].astype(y.dtype)
    return jnp.zeros_like(h).at[bidx, idx].add(y)


def setup_inputs(seed: int = 0) -> dict:
    key = jax.random.key(seed)
    ks = jax.random.split(key, 32)
    L, D, F, E = DEPTH, D_MODEL, EXPERT_HIDDEN, N_EXPERTS

    def nrm(k, shape, scale):
        return jax.random.normal(k, shape, jnp.float32) * scale

    return {
        'x': nrm(ks[0], (BATCH, SEQ, D), 1.0),
        'c': nrm(ks[1], (BATCH, D), 1.0),
        'ctx': nrm(ks[2], (BATCH, CTX_LEN, D), 1.0),
        'c_ctx': nrm(ks[3], (D,), 1.0),
        'norm1_g': 1.0 + nrm(ks[4], (L, D), 0.02),
        'norm2_g': 1.0 + nrm(ks[5], (L, D), 0.02),
        'w_ada': nrm(ks[6], (L, D, 6 * D), 0.5 * D ** -0.5),
        'b_ada': nrm(ks[7], (L, 6 * D), 0.02),
        'w_in': nrm(ks[8], (L, D, PROJ_COLS), D ** -0.5),
        'conv_w': nrm(ks[9], (L, CONV_K, CONV_WIDTH), CONV_K ** -0.5),
        'w_out_conv': nrm(ks[10], (L, CONV_WIDTH, D), CONV_WIDTH ** -0.5),
        'lambda_q1': nrm(ks[11], (L, HEAD_DIM), 0.1),
        'lambda_k1': nrm(ks[12], (L, HEAD_DIM), 0.1),
        'lambda_q2': nrm(ks[13], (L, HEAD_DIM), 0.1),
        'lambda_k2': nrm(ks[14], (L, HEAD_DIM), 0.1),
        'subln_g': 1.0 + nrm(ks[15], (L, V_DIM), 0.02),
        'w_o_attn': nrm(ks[16], (L, ATTN_V, D), ATTN_V ** -0.5),
        'w_out': nrm(ks[17], (L, D, D), D ** -0.5),
        'w_router': nrm(ks[18], (L, D, E), D ** -0.5),
        'w_gate_e': nrm(ks[19], (L, E, D, F), D ** -0.5),
        'w_up_e': nrm(ks[20], (L, E, D, F), D ** -0.5),
        'w_down_e': nrm(ks[21], (L, E, F, D), F ** -0.5),
        'final_g': 1.0 + nrm(ks[22], (D,), 0.02),
    }


def reference(x, c, ctx, c_ctx, norm1_g, norm2_g, w_ada, b_ada, w_in, conv_w, w_out_conv,
              lambda_q1, lambda_k1, lambda_q2, lambda_k2, subln_g, w_o_attn, w_out,
              w_router, w_gate_e, w_up_e, w_down_e, final_g):
    n = x.shape[1]
    cos, sin = axial_rope_tables(n)
    f32 = jnp.float32
    for l in range(DEPTH):
        last = l == DEPTH - 1
        sh1, sc1, g1, sh2, sc2, g2 = ada_mod(c, w_ada[l], b_ada[l])
        sh1c, sc1c, g1c, sh2c, sc2c, g2c = ada_mod(c_ctx, w_ada[l], b_ada[l])
        lam_init = 0.8 - 0.6 * math.exp(-0.3 * l)
        lam = (jnp.exp(jnp.sum(lambda_q1[l].astype(f32) * lambda_k1[l].astype(f32)))
               - jnp.exp(jnp.sum(lambda_q2[l].astype(f32) * lambda_k2[l].astype(f32)))
               + lam_init)

        hx = modulate(rmsnorm(x, norm1_g[l]), sh1, sc1)
        hc = modulate(rmsnorm(ctx, norm1_g[l]), sh1c, sc1c)
        px = split_proj(hx @ w_in[l])
        pc = split_proj(hc @ w_in[l])
        qx, kx, vx = attn_heads(px)
        qc, kc, vc = attn_heads(pc)
        qx = apply_rope(qx, cos, sin)
        kx = apply_rope(kx, cos, sin)
        k_all = jnp.concatenate([to_bhm(kc), to_bhm(kx)], axis=3)
        v_all = jnp.concatenate([vc, vx], axis=2)
        ox = blocked_diff_attn(to_bhm(qx), k_all, v_all, lam)
        mix_x = merge_branches(px, ox, conv_w[l], w_out_conv[l], subln_g[l], lam_init,
                               w_o_attn[l], w_out[l])
        x = x + g1 * mix_x
        if not last:
            oc = diff_attn(to_bhm(qc), to_bhm(kc), vc, lam)
            ctx = ctx + g1c * merge_branches(pc, oc, conv_w[l], w_out_conv[l], subln_g[l],
                                             lam_init, w_o_attn[l], w_out[l])

        hx2 = modulate(rmsnorm(x, norm2_g[l]), sh2, sc2)
        x = x + g2 * expert_choice_ffn(hx2, w_router[l], w_gate_e[l], w_up_e[l], w_down_e[l])
        if not last:
            hc2 = modulate(rmsnorm(ctx, norm2_g[l]), sh2c, sc2c)
            ctx = ctx + g2c * expert_choice_ffn(hc2, w_router[l], w_gate_e[l], w_up_e[l], w_down_e[l])
    return rmsnorm(x, final_g)
```

```cpp
#include <hip/hip_runtime.h>
#include <cstdio>
#include <cstdint>

#ifndef MK_N_LAUNCHES
#define MK_N_LAUNCHES 1
#endif
#ifndef MK_PROBE_LO
#define MK_PROBE_LO -1
#define MK_PROBE_HI -1
#endif
constexpr int N_PHASES = 11;
constexpr int N_LAUNCHES = MK_N_LAUNCHES;

constexpr int DM = 1024, NB = 8, SEQ = 2048, CTXL = 256;
constexpr int MX = NB * SEQ;
constexpr int MC = NB * CTXL;
constexpr int MA = MX + MC;
constexpr int SKV = CTXL + SEQ;
constexpr int NH = 8;
constexpr int NE = 16, FH = 2048, CAP = 256;
constexpr int MS = NE * NB * CAP;
constexpr int NMOD = 6 * DM;
constexpr float EPS = 1e-6f;
constexpr float LAM_INIT = 0.2f;

constexpr size_t MiB = 1u << 20;
constexpr size_t WS_CTL = 0, CTL_ZERO_BYTES = 64 * 1024;
constexpr size_t WS_MODS = 1 * MiB;
constexpr size_t WS_AFF = 2 * MiB;
constexpr size_t WS_SLOT = 3 * MiB;
constexpr size_t WS_GATE = 4 * MiB;
constexpr size_t WS_GIDX = 5 * MiB;
constexpr size_t WS_WIN = 8 * MiB;
constexpr size_t WS_WC = 24 * MiB, WS_WO = 26 * MiB, WS_WOUT = 28 * MiB;
constexpr size_t WS_Z = 32 * MiB, WS_GB = 64 * MiB, WS_Q = 96 * MiB, WS_KALL = 128 * MiB, WS_VALL = 164 * MiB, WS_S6 = 200 * MiB, WS_S7 = 232 * MiB;
constexpr size_t WS_H = 32 * MiB;
constexpr size_t WS_WGU = 428 * MiB;
constexpr size_t WS_A1 = 264 * MiB;
constexpr size_t WS_HX2 = 288 * MiB;
constexpr size_t WS_YG = 288 * MiB;
constexpr size_t WS_OATT = 300 * MiB;
constexpr size_t WS_MERGED = 332 * MiB;
constexpr size_t WS_O1 = 364 * MiB;
constexpr size_t WS_MIX = 364 * MiB;
constexpr size_t WS_WD = 396 * MiB;
constexpr size_t WS_END = 492 * MiB;

constexpr int RING_BYTES = 131072;
constexpr int ROPE_OFF = RING_BYTES;
constexpr int GTAB_OFF = ROPE_OFF + 8192;
constexpr int LDSCTL_OFF = GTAB_OFF + 8192, MISC_OFF = LDSCTL_OFF + 320;
constexpr int LDS_BYTES = 155648;

#define GAS __attribute__((address_space(1)))
#define LAS __attribute__((address_space(3)))
typedef unsigned short bf16_t;
typedef unsigned v4u __attribute__((ext_vector_type(4)));
typedef unsigned v2u __attribute__((ext_vector_type(2)));
typedef float f32x4 __attribute__((ext_vector_type(4)));
typedef float f32x2 __attribute__((ext_vector_type(2)));
typedef short bf16x8 __attribute__((ext_vector_type(8)));
typedef GAS unsigned gu32;
#define RLX_AGENT __ATOMIC_RELAXED, __HIP_MEMORY_SCOPE_AGENT
#define LDS_WAIT() asm volatile("s_waitcnt lgkmcnt(0)" ::: "memory")
#define VM_WAIT() asm volatile("s_waitcnt vmcnt(0)" ::: "memory")

__device__ __forceinline__ unsigned f2bf(float f) { unsigned u = __builtin_bit_cast(unsigned, f); return (u + 0x7fffu + ((u >> 16) & 1u)) >> 16; }
__device__ __forceinline__ unsigned pk2(float lo, float hi) { return f2bf(lo) | (f2bf(hi) << 16); }
__device__ __forceinline__ float bf_lo(unsigned w) { return __builtin_bit_cast(float, w << 16); }
__device__ __forceinline__ float bf_hi(unsigned w) { return __builtin_bit_cast(float, w & 0xffff0000u); }
__device__ __forceinline__ unsigned cvt_pk_bf16(float lo, float hi) { unsigned r; asm volatile("v_cvt_pk_bf16_f32 %0, %1, %2" : "=v"(r) : "v"(lo), "v"(hi)); return r; }
__device__ __forceinline__ float wave_sum(float v) {
#pragma unroll
    for (int o = 1; o < 64; o <<= 1) v += __shfl_xor(v, o);
    return v;
}
__device__ __forceinline__ float swap32(float v, bool lo_half) {
    auto r = __builtin_amdgcn_permlane32_swap(__builtin_bit_cast(unsigned, v), __builtin_bit_cast(unsigned, v), false, false);
    return __builtin_bit_cast(float, lo_half ? r[1] : r[0]);
}
__device__ __forceinline__ unsigned pk_fp8x4(float a, float b, float c, float d) {
    a = __builtin_amdgcn_fmed3f(a, -448.f, 448.f); b = __builtin_amdgcn_fmed3f(b, -448.f, 448.f); c = __builtin_amdgcn_fmed3f(c, -448.f, 448.f); d = __builtin_amdgcn_fmed3f(d, -448.f, 448.f);
    int w = 0; w = __builtin_amdgcn_cvt_pk_fp8_f32(a, b, w, false); w = __builtin_amdgcn_cvt_pk_fp8_f32(c, d, w, true); return (unsigned)w; }
__device__ __forceinline__ float sigmoidf_(float x) { return __builtin_amdgcn_rcpf(1.f + __builtin_amdgcn_exp2f(-1.4426950408889634f * x)); }

namespace pg8 {
#define PG8_LAS __attribute__((address_space(3)))
typedef float f32x4 __attribute__((ext_vector_type(4)));
typedef unsigned u32x4 __attribute__((ext_vector_type(4)));
typedef int v4i_ __attribute__((ext_vector_type(4)));
typedef int v8i_ __attribute__((ext_vector_type(8)));
constexpr int BM = 256, BK = 64, HALF = 128, HTB = HALF * BK * 2, STAGE_BYTES = 8 * HTB, NXCD = 8, WGM = 8;

__host__ __device__ __forceinline__ int lds_byte(int r, int c) { const int st = (r >> 4) * 2 + (c >> 5), rr = r & 15, cc = c & 31, ob = rr * 64 + cc * 2; return st * 1024 + (ob ^ (((ob >> 9) & 1) << 5)); }
__host__ __device__ __forceinline__ void stage_rc(int b, int& R, int& C) { const int st = b / 1024, sb = b % 1024, swz = sb ^ (((sb >> 9) & 1) << 5); R = (st >> 1) * 16 + swz / 64; C = (st & 1) * 32 + (swz % 64) / 2; }
__host__ __device__ __forceinline__ int perm32(int rho) { const int n = rho >> 4, i = rho & 15; return 8 * (i >> 2) + 4 * n + (i & 3); }

struct Unit { int pm, pb, pn; };
struct Gemm { const bf16_t* A; const bf16_t* Bt; int K; };

struct OrdGrid {
    int nM, nN, nwg, G, c;
    __device__ __forceinline__ void init(int nM_, int nN_, int G_, int c_) { nM = nM_; nN = nN_; nwg = nM * nN; G = G_; c = c_; }
    __device__ __forceinline__ bool next(int i, Unit& u) const {
        const long L = (long)i * G + c; if (L >= nwg) return false;
        int wgid = (int)L; { const int q = nwg / NXCD, xcd = wgid % NXCD, off = wgid / NXCD; wgid = xcd * q + off; }
        const int nig = WGM * nN, gid = wgid / nig, fm = gid * WGM;
        u.pm = fm + ((wgid % nig) % WGM); u.pn = (wgid % nig) / WGM; u.pb = u.pn; return true;
    }
};
struct OrdMerge {
    OrdGrid base; int pmA0, pmA1, pbB0, pbB1;
    __device__ __forceinline__ bool next(int i, Unit& u) const {
        Unit t; if (!base.next(i >> 1, t)) return false;
        const int ty = i & 1; u.pm = (ty ? pmA1 : pmA0) + t.pm; u.pb = (ty ? pbB1 : pbB0) + t.pn; u.pn = ty * 4 + t.pn + 8 * t.pm; return true;
    }
};
struct OrdInProj {
    int G, c;
    __device__ __forceinline__ bool next(int i, Unit& u) const {
        const long L = (long)i * G + c; if (L >= 2048 + 64) return false;
        if (L < 2048) { const int wgid = (int)(L % 8) * 256 + (int)(L / 8); const int w = wgid % 256; u.pm = (wgid / 256) * 8 + (w % 8); u.pn = w / 8; }
        else { const int l2 = (int)L - 2048; u.pm = 64 + (l2 & 7); u.pn = 16 + (l2 >> 3); }
        u.pb = u.pn; return true;
    }
};
template <int NT> struct OrdMoe {
    int G, c, i0, imax;
    __device__ __forceinline__ bool next(int i, Unit& u) const {
        constexpr int nwg = 128 * NT;
        if (i >= imax) return false;
        const long L = (long)(i0 + i) * G + c; if (L >= nwg) return false;
        const int wgid = (int)(L % 8) * (nwg / 8) + (int)(L / 8);
        const int e = wgid / (8 * NT), w = wgid % (8 * NT);
        u.pm = e * 8 + (w % 8); u.pn = w / 8; u.pb = e * NT + u.pn; return true;
    }
};

template <class Epi, class Sched, bool ALIGN_EPI = false, bool SP2 = false, bool GATHER = false, bool FP8 = false>
__device__ __forceinline__ void gemm_phase(PG8_LAS unsigned char* lds, const Gemm g, const Sched& S, const Epi& E, const PG8_LAS unsigned* gtab = nullptr) {
    const int tid = threadIdx.x, wid = __builtin_amdgcn_readfirstlane(tid >> 6), lane = tid & 63, wr = wid >> 2, wc = wid & 3, fr = lane & 15, fq = lane >> 4;
    const int K = g.K, nt = K / BK;
    unsigned voffA[2], voffB[2];
#pragma unroll
    for (int i = 0; i < 2; ++i) { int R, C; stage_rc(tid * 16 + i * 8192, R, C); const int Rb = ((R & ~31) + perm32(R & 31));
        voffA[i] = (unsigned)(R * K + C) * 2u; voffB[i] = (unsigned)(Rb * K + C) * 2u; }
    const size_t kstep = (size_t)(BK * 2);
    const size_t hstep = (size_t)HALF * K * 2;
    const size_t tstep = 2 * hstep;
    const unsigned ldsw = (unsigned)wid * 1024u;
    int gR[2], gC2[2];
#pragma unroll
    for (int i = 0; i < 2; ++i) { int R, C; stage_rc(tid * 16 + i * 8192, R, C); gR[i] = R; gC2[i] = C * 2; }
    unsigned cO0[2], cO1[2], nO0[2], nO1[2];
#define PG8_GOFF(O0, O1, ui_) do { _Pragma("unroll") for (int _i = 0; _i < 2; ++_i) { O0[_i] = gtab[((ui_) & 7) * 256 + gR[_i]] + gC2[_i]; O1[_i] = gtab[((ui_) & 7) * 256 + 128 + gR[_i]] + gC2[_i]; } } while (0)
    const int aoff = lds_byte(wr * 64 + fr, fq * 8), boff = lds_byte(wc * 32 + fr, fq * 8);
#define PG8_SA(b, h) (((b) * 2 + (h)) * HTB)
#define PG8_SB(b, h) ((4 + (b) * 2 + (h)) * HTB)
#define PG8_STAGE(bufoff, gbase, voff) do { _Pragma("unroll") for (int _i = 0; _i < 2; ++_i) \
        __builtin_amdgcn_global_load_lds((const unsigned*)((const char*)(gbase) + (voff)[_i]), (PG8_LAS unsigned*)(lds + (bufoff) + ldsw + _i * 8192), 16, 0, 0); } while (0)
#define PG8_LD8(p) __builtin_shufflevector(*(const PG8_LAS v4i_*)(p), *(const PG8_LAS v4i_*)((p) + 1024), 0, 1, 2, 3, 4, 5, 6, 7)
#define PG8_LDA(dst, b, h) do { if constexpr (FP8) { _Pragma("unroll") for (int m = 0; m < 4; ++m) dst##8[m] = PG8_LD8(lds + PG8_SA(b, h) + aoff + m * 2048); } \
        else { _Pragma("unroll") for (int m = 0; m < 4; ++m) _Pragma("unroll") for (int k = 0; k < 2; ++k) dst[m][k] = *(const PG8_LAS bf16x8*)(lds + PG8_SA(b, h) + aoff + m * 2048 + k * 1024); } } while (0)
#define PG8_LDB(dst, b, h) do { if constexpr (FP8) { _Pragma("unroll") for (int n = 0; n < 2; ++n) dst##8[n] = PG8_LD8(lds + PG8_SB(b, h) + boff + n * 2048); } \
        else { _Pragma("unroll") for (int n = 0; n < 2; ++n) _Pragma("unroll") for (int k = 0; k < 2; ++k) dst[n][k] = *(const PG8_LAS bf16x8*)(lds + PG8_SB(b, h) + boff + n * 2048 + k * 1024); } } while (0)
#define PG8_MMA(ai, bj, At, Bt) do { __builtin_amdgcn_s_setprio(1); _Pragma("unroll") for (int m = 0; m < 4; ++m) _Pragma("unroll") for (int n = 0; n < 2; ++n) { \
        if constexpr (FP8) asm("v_mfma_scale_f32_16x16x128_f8f6f4 %0, %1, %2, %0, %3, %4 op_sel_hi:[0,0,0]" : "+v"(acc[ai][bj][m][n]) : "v"(Bt##8[n]), "v"(At##8[m]), "v"(scw8), "v"(sca8)); \
        else { _Pragma("unroll") for (int k = 0; k < 2; ++k) acc[ai][bj][m][n] = __builtin_amdgcn_mfma_f32_16x16x32_bf16(Bt[n][k], At[m][k], acc[ai][bj][m][n], 0, 0, 0); } } __builtin_amdgcn_s_setprio(0); } while (0)
#define PG8_WAIT_V(n) asm volatile("s_waitcnt vmcnt(" #n ")" ::: "memory")
#define PG8_WAIT_L(n) asm volatile("s_waitcnt lgkmcnt(" #n ")" ::: "memory")
#define PG8_BAR __builtin_amdgcn_s_barrier()
#define PG8_SCHED __builtin_amdgcn_sched_barrier(0)
    Unit cur, nxt; int ui = 0;
    if (!S.next(0, cur)) return;
    f32x4 acc[2][2][4][2];
#pragma unroll
    for (int a = 0; a < 2; ++a)
#pragma unroll
        for (int b = 0; b < 2; ++b)
#pragma unroll
            for (int m = 0; m < 4; ++m)
#pragma unroll
                for (int n = 0; n < 2; ++n) acc[a][b][m][n] = (f32x4){0.f, 0.f, 0.f, 0.f};
    int scw8 = 0x7b7b7b7b, sca8 = 0x7f7f7f7f; asm volatile("" : "+v"(scw8), "+v"(sca8));
    bf16x8 At[4][2], B0[2][2], B1[2][2]; v8i_ At8[4], B08[2], B18[2];
    const char* cA = GATHER ? (const char*)g.A : (const char*)g.A + (size_t)cur.pm * tstep; const char* cB = (const char*)g.Bt + (size_t)cur.pb * tstep;
    if constexpr (GATHER) { PG8_GOFF(cO0, cO1, 0); }
    if constexpr (SP2 && GATHER) {
        PG8_STAGE(PG8_SB(0, 0), cB, voffB); PG8_STAGE(PG8_SB(0, 1), cB + hstep, voffB); PG8_STAGE(PG8_SA(0, 0), cA, cO0); PG8_STAGE(PG8_SA(0, 1), cA, cO1);
        if (wr == 1) PG8_BAR;
        PG8_WAIT_V(2); PG8_BAR;
        PG8_STAGE(PG8_SB(1, 0), cB + kstep, voffB); PG8_STAGE(PG8_SA(1, 0), cA + kstep, cO0); PG8_STAGE(PG8_SB(1, 1), cB + hstep + kstep, voffB);
        PG8_WAIT_V(6); PG8_BAR;
    } else if constexpr (SP2) {
        PG8_STAGE(PG8_SB(0, 0), cB, voffB); PG8_STAGE(PG8_SB(0, 1), cB + hstep, voffB); PG8_STAGE(PG8_SA(0, 0), cA, voffA); PG8_STAGE(PG8_SA(0, 1), cA + hstep, voffA);
        if (wr == 1) PG8_BAR;
        PG8_WAIT_V(2); PG8_BAR;
        PG8_STAGE(PG8_SB(1, 0), cB + kstep, voffB); PG8_STAGE(PG8_SA(1, 0), cA + kstep, voffA); PG8_STAGE(PG8_SB(1, 1), cB + hstep + kstep, voffB);
        PG8_WAIT_V(6); PG8_BAR;
    } else {
        PG8_STAGE(PG8_SB(0, 0), cB, voffB); PG8_STAGE(PG8_SA(0, 0), cA, voffA); PG8_STAGE(PG8_SB(0, 1), cB + hstep, voffB); PG8_STAGE(PG8_SA(0, 1), cA + hstep, voffA);
        if (wr == 1) PG8_BAR;
        PG8_WAIT_V(4); PG8_BAR;
        PG8_STAGE(PG8_SB(1, 0), cB + kstep, voffB); PG8_STAGE(PG8_SA(1, 0), cA + kstep, voffA); PG8_STAGE(PG8_SB(1, 1), cB + hstep + kstep, voffB);
        PG8_WAIT_V(6); PG8_BAR;
    }
    for (;;) {
        const bool has_next = S.next(ui + 1, nxt);
        const char* nA = GATHER ? cA : (has_next ? (const char*)g.A + (size_t)nxt.pm * tstep : cA); const char* nB = has_next ? (const char*)g.Bt + (size_t)nxt.pb * tstep : cB;
        if constexpr (GATHER) { if (has_next) { PG8_GOFF(nO0, nO1, ui + 1); } else {
#pragma unroll
            for (int _i = 0; _i < 2; ++_i) { nO0[_i] = cO0[_i]; nO1[_i] = cO1[_i]; } } }
        for (int t = 0; t < nt; t += 2) {
            const bool last = (t == nt - 2);
            const char* a1 = cA + (size_t)(t + 1) * kstep;
            const char* a2 = last ? nA : cA + (size_t)(t + 2) * kstep; const char* b2 = last ? nB : cB + (size_t)(t + 2) * kstep;
            const char* a3 = a2 + kstep; const char* b3 = b2 + kstep;
            if constexpr (SP2 && GATHER) {
            unsigned s0[2], s1[2];
#pragma unroll
            for (int _i = 0; _i < 2; ++_i) { s0[_i] = last ? nO0[_i] : cO0[_i]; s1[_i] = last ? nO1[_i] : cO1[_i]; }
            const char* g2 = last ? cA : cA + (size_t)(t + 2) * kstep; const char* g3 = g2 + kstep;
            PG8_LDB(B0, 0, 0); PG8_LDB(B1, 0, 1); PG8_SCHED; PG8_LDA(At, 0, 0); PG8_STAGE(PG8_SA(1, 1), a1, cO1);
            PG8_WAIT_V(8); PG8_WAIT_L(0); PG8_BAR; PG8_MMA(0, 0, At, B0); PG8_MMA(0, 1, At, B1); PG8_BAR; PG8_SCHED;
            PG8_LDA(At, 0, 1); PG8_STAGE(PG8_SB(0, 0), b2, voffB); PG8_STAGE(PG8_SB(0, 1), b2 + hstep, voffB); PG8_STAGE(PG8_SA(0, 0), g2, s0);
            PG8_WAIT_V(8); PG8_WAIT_L(0); PG8_BAR; PG8_MMA(1, 0, At, B0); PG8_MMA(1, 1, At, B1); PG8_BAR; PG8_SCHED;
            PG8_LDB(B0, 1, 0); PG8_LDB(B1, 1, 1); PG8_SCHED; PG8_LDA(At, 1, 0); PG8_STAGE(PG8_SA(0, 1), g2, s1);
            PG8_WAIT_V(8); PG8_WAIT_L(0); PG8_BAR; PG8_MMA(0, 0, At, B0); PG8_MMA(0, 1, At, B1); PG8_BAR; PG8_SCHED;
            PG8_LDA(At, 1, 1); PG8_STAGE(PG8_SB(1, 0), b3, voffB); PG8_STAGE(PG8_SB(1, 1), b3 + hstep, voffB); PG8_STAGE(PG8_SA(1, 0), g3, s0);
            PG8_WAIT_V(8); PG8_WAIT_L(0); PG8_BAR; PG8_MMA(1, 0, At, B0); PG8_MMA(1, 1, At, B1); PG8_BAR; PG8_SCHED;
            } else if constexpr (SP2) {
            PG8_LDB(B0, 0, 0); PG8_LDB(B1, 0, 1); PG8_SCHED; PG8_LDA(At, 0, 0); PG8_STAGE(PG8_SA(1, 1), a1 + hstep, voffA);
            PG8_WAIT_V(8); PG8_WAIT_L(0); PG8_BAR; PG8_MMA(0, 0, At, B0); PG8_MMA(0, 1, At, B1); PG8_BAR; PG8_SCHED;
            PG8_LDA(At, 0, 1); PG8_STAGE(PG8_SB(0, 0), b2, voffB); PG8_STAGE(PG8_SB(0, 1), b2 + hstep, voffB); PG8_STAGE(PG8_SA(0, 0), a2, voffA);
            PG8_WAIT_V(8); PG8_WAIT_L(0); PG8_BAR; PG8_MMA(1, 0, At, B0); PG8_MMA(1, 1, At, B1); PG8_BAR; PG8_SCHED;
            PG8_LDB(B0, 1, 0); PG8_LDB(B1, 1, 1); PG8_SCHED; PG8_LDA(At, 1, 0); PG8_STAGE(PG8_SA(0, 1), a2 + hstep, voffA);
            PG8_WAIT_V(8); PG8_WAIT_L(0); PG8_BAR; PG8_MMA(0, 0, At, B0); PG8_MMA(0, 1, At, B1); PG8_BAR; PG8_SCHED;
            PG8_LDA(At, 1, 1); PG8_STAGE(PG8_SB(1, 0), b3, voffB); PG8_STAGE(PG8_SB(1, 1), b3 + hstep, voffB); PG8_STAGE(PG8_SA(1, 0), a3, voffA);
            PG8_WAIT_V(8); PG8_WAIT_L(0); PG8_BAR; PG8_MMA(1, 0, At, B0); PG8_MMA(1, 1, At, B1); PG8_BAR; PG8_SCHED;
            } else {
            PG8_LDB(B0, 0, 0); PG8_SCHED; PG8_LDA(At, 0, 0); PG8_STAGE(PG8_SA(1, 1), a1 + hstep, voffA);
            PG8_WAIT_L(8); PG8_BAR; PG8_WAIT_L(0); PG8_MMA(0, 0, At, B0); PG8_BAR; PG8_SCHED;
            PG8_LDB(B1, 0, 1); PG8_STAGE(PG8_SB(0, 0), b2, voffB);
            PG8_BAR; PG8_WAIT_L(0); PG8_MMA(0, 1, At, B1); PG8_BAR;
            PG8_LDA(At, 0, 1); PG8_STAGE(PG8_SA(0, 0), a2, voffA);
            PG8_BAR; PG8_WAIT_L(0); PG8_MMA(1, 0, At, B0); PG8_BAR; PG8_SCHED;
            PG8_STAGE(PG8_SB(0, 1), b2 + hstep, voffB);
            PG8_WAIT_V(6); PG8_BAR; PG8_MMA(1, 1, At, B1); PG8_BAR;
            PG8_LDB(B0, 1, 0); PG8_SCHED; PG8_LDA(At, 1, 0); PG8_STAGE(PG8_SA(0, 1), a2 + hstep, voffA);
            PG8_WAIT_L(8); PG8_BAR; PG8_WAIT_L(0); PG8_MMA(0, 0, At, B0); PG8_BAR; PG8_SCHED;
            PG8_LDB(B1, 1, 1); PG8_STAGE(PG8_SB(1, 0), b3, voffB);
            PG8_BAR; PG8_WAIT_L(0); PG8_MMA(0, 1, At, B1); PG8_BAR;
            PG8_LDA(At, 1, 1); PG8_STAGE(PG8_SA(1, 0), a3, voffA);
            PG8_BAR; PG8_WAIT_L(0); PG8_MMA(1, 0, At, B0); PG8_BAR; PG8_SCHED;
            PG8_STAGE(PG8_SB(1, 1), b3 + hstep, voffB);
            PG8_WAIT_V(6); PG8_BAR; PG8_MMA(1, 1, At, B1); PG8_BAR;
            }
        }
        if constexpr (ALIGN_EPI) { if (wr == 0) PG8_BAR; }
        if constexpr (FP8) asm volatile("s_nop 15\n\ts_nop 15" ::: "memory");
        E(acc, cur, wr, wc, fr, fq);
        if (!has_next) break;
        if (!Epi::keep_acc(cur)) {
#pragma unroll
        for (int a = 0; a < 2; ++a)
#pragma unroll
            for (int b = 0; b < 2; ++b)
#pragma unroll
                for (int m = 0; m < 4; ++m)
#pragma unroll
                    for (int n = 0; n < 2; ++n) acc[a][b][m][n] = (f32x4){0.f, 0.f, 0.f, 0.f}; }
        if constexpr (FP8) asm volatile("s_nop 4" ::: "memory");
        cur = nxt; cA = nA; cB = nB; ++ui;
        if constexpr (GATHER) {
#pragma unroll
            for (int _i = 0; _i < 2; ++_i) { cO0[_i] = nO0[_i]; cO1[_i] = nO1[_i]; } }
        if constexpr (ALIGN_EPI) { if (wr == 1) PG8_BAR; }
    }
    PG8_WAIT_V(0);
    if constexpr (!ALIGN_EPI) { if (wr == 0) PG8_BAR; }
    PG8_BAR;
#undef PG8_GOFF
#undef PG8_SA
#undef PG8_SB
#undef PG8_STAGE
#undef PG8_LDA
#undef PG8_LDB
#undef PG8_MMA
#undef PG8_LD8
#undef PG8_WAIT_V
#undef PG8_WAIT_L
#undef PG8_BAR
#undef PG8_SCHED
}

typedef f32x4 Acc[2][2][4][2];
__device__ __forceinline__ v4u pack8(f32x4 v0, f32x4 v1) { v4u w; w.x = cvt_pk_bf16(v0[0], v0[1]); w.y = cvt_pk_bf16(v0[2], v0[3]); w.z = cvt_pk_bf16(v1[0], v1[1]); w.w = cvt_pk_bf16(v1[2], v1[3]); return w; }
__device__ __forceinline__ void unpack8(v4u w, f32x4& v0, f32x4& v1) { v0 = (f32x4){bf_lo(w.x), bf_hi(w.x), bf_lo(w.y), bf_hi(w.y)}; v1 = (f32x4){bf_lo(w.z), bf_hi(w.z), bf_lo(w.w), bf_hi(w.w)}; }

struct EpiInProj {
    bf16_t *Z, *GB, *Q, *KALL, *VALL, *S6, *S7; const LAS float* rope;
    static __device__ __forceinline__ bool keep_acc(const Unit&) { return false; }
    __device__ __forceinline__ void operator()(Acc& acc, const Unit& u, int wr, int wc, int fr, int fq) const {
        const int pn = u.pn, row0 = u.pm * BM + wr * 64 + fr, cw = wc * 32 + 8 * fq;
        if (pn < 8) {
#pragma unroll
            for (int ai = 0; ai < 2; ++ai)
#pragma unroll
                for (int m = 0; m < 4; ++m) { const int row = row0 + ai * HALF + m * 16;
                    *(v4u*)(Z + (size_t)row * DM + pn * 128 + cw) = pack8(acc[ai][0][m][0] * acc[ai][1][m][0], acc[ai][0][m][1] * acc[ai][1][m][1]); }
        } else if (pn < 12) {
#pragma unroll
            for (int ai = 0; ai < 2; ++ai)
#pragma unroll
                for (int m = 0; m < 4; ++m) { const int row = row0 + ai * HALF + m * 16;
#pragma unroll
                    for (int bj = 0; bj < 2; ++bj) *(v4u*)(GB + (size_t)row * DM + (pn - 8) * 256 + bj * HALF + cw) = pack8(acc[ai][bj][m][0], acc[ai][bj][m][1]); }
        } else if (pn < 20) {
            const bool isK = pn >= 16, ctx = u.pm >= 64; const int colb = (pn - (isK ? 16 : 12)) * 256 + cw;
            const bool lo_half = fq < 2; const float sgn = lo_half ? -1.f : 1.f; const int axis = wc & 1, fsel = (fq & 1) * 8;
#pragma unroll
            for (int ai = 0; ai < 2; ++ai)
#pragma unroll
                for (int m = 0; m < 4; ++m) { const int row = row0 + ai * HALF + m * 16;
                    size_t orow; f32x4 cs[4] = {};
                    if (ctx) { const int rc = row - MX; orow = (size_t)(rc >> 8) * SKV + (rc & 255); }
                    else { const int t = row & (SEQ - 1), pos = axis ? (t & 63) : (t >> 6); orow = isK ? (size_t)(row >> 11) * SKV + CTXL + t : (size_t)row;
                        const LAS f32x4* tb = (const LAS f32x4*)(rope + (pos * 16 + fsel) * 2);
#pragma unroll
                        for (int i = 0; i < 4; ++i) cs[i] = tb[i]; }
                    bf16_t* dst = (isK ? KALL : Q) + orow * DM + colb;
#pragma unroll
                    for (int bj = 0; bj < 2; ++bj)
#pragma unroll
                        for (int n = 0; n < 2; ++n) { f32x4 o;
#pragma unroll
                            for (int j = 0; j < 4; ++j) { const float own = acc[ai][bj][m][n][j];
                                if (ctx) o[j] = own;
                                else { const float par = swap32(own, lo_half); const int f = 4 * n + j; const float c = cs[f >> 1][(f & 1) * 2], s = cs[f >> 1][(f & 1) * 2 + 1]; o[j] = own * c + par * (sgn * s); } }
                            v2u w; w.x = cvt_pk_bf16(o[0], o[1]); w.y = cvt_pk_bf16(o[2], o[3]); *(v2u*)(dst + bj * HALF + 4 * n) = w; }
                    asm volatile("" ::: "memory"); }
        } else if (pn < 24) {
            const bool ctx = u.pm >= 64;
#pragma unroll
            for (int ai = 0; ai < 2; ++ai)
#pragma unroll
                for (int m = 0; m < 4; ++m) { const int row = row0 + ai * HALF + m * 16;
                    size_t orow; if (ctx) { const int rc = row - MX; orow = (size_t)(rc >> 8) * SKV + (rc & 255); } else orow = (size_t)(row >> 11) * SKV + CTXL + (row & (SEQ - 1));
#pragma unroll
                    for (int bj = 0; bj < 2; ++bj) *(v4u*)(VALL + orow * DM + (pn - 20) * 256 + bj * HALF + cw) = pack8(acc[ai][bj][m][0], acc[ai][bj][m][1]); }
        } else {
            bf16_t* dstb = pn < 28 ? S6 : S7; const int colb = (pn - (pn < 28 ? 24 : 28)) * 256 + cw;
#pragma unroll
            for (int ai = 0; ai < 2; ++ai)
#pragma unroll
                for (int m = 0; m < 4; ++m) { const int row = row0 + ai * HALF + m * 16;
#pragma unroll
                    for (int bj = 0; bj < 2; ++bj) { f32x4 a = acc[ai][bj][m][0], b = acc[ai][bj][m][1];
#pragma unroll
                        for (int j = 0; j < 4; ++j) { a[j] = sigmoidf_(a[j]); b[j] = sigmoidf_(b[j]); }
                        *(v4u*)(dstb + (size_t)row * DM + colb + bj * HALF) = pack8(a, b); } }
        }
    }
};
struct EpiT1 {
    const bf16_t* S6; float* T;
    static __device__ __forceinline__ bool keep_acc(const Unit&) { return false; }
    __device__ __forceinline__ void operator()(Acc& acc, const Unit& u, int wr, int wc, int fr, int fq) const {
        const int row0 = u.pm * BM + wr * 64 + fr, col0 = u.pn * BM + wc * 32 + 8 * fq;
#pragma unroll
        for (int ai = 0; ai < 2; ++ai)
#pragma unroll
            for (int m = 0; m < 4; ++m) { const size_t off = (size_t)(row0 + ai * HALF + m * 16) * DM + col0;
#pragma unroll
                for (int bj = 0; bj < 2; ++bj) { f32x4 g0, g1; unpack8(*(const v4u*)(S6 + off + bj * HALF), g0, g1);
                    *(f32x4*)(T + off + bj * HALF) = g0 * acc[ai][bj][m][0]; *(f32x4*)(T + off + bj * HALF + 4) = g1 * acc[ai][bj][m][1]; } }
    }
};
struct EpiT2 {
    const bf16_t* S7; const float* T; bf16_t* MG;
    static __device__ __forceinline__ bool keep_acc(const Unit&) { return false; }
    __device__ __forceinline__ void operator()(Acc& acc, const Unit& u, int wr, int wc, int fr, int fq) const {
        const int row0 = u.pm * BM + wr * 64 + fr, col0 = u.pn * BM + wc * 32 + 8 * fq;
#pragma unroll
        for (int ai = 0; ai < 2; ++ai)
#pragma unroll
            for (int m = 0; m < 4; ++m) { const size_t off = (size_t)(row0 + ai * HALF + m * 16) * DM + col0;
#pragma unroll
                for (int bj = 0; bj < 2; ++bj) { f32x4 g0, g1; unpack8(*(const v4u*)(S7 + off + bj * HALF), g0, g1);
                    const f32x4 t0 = *(const f32x4*)(T + off + bj * HALF), t1 = *(const f32x4*)(T + off + bj * HALF + 4);
                    *(v4u*)(MG + off + bj * HALF) = pack8(t0 + g0 * acc[ai][bj][m][0], t1 + g1 * acc[ai][bj][m][1]); } }
    }
};
struct EpiMerge {
    const bf16_t* S6; const bf16_t* S7; bf16_t* MG;
    static __device__ __forceinline__ bool keep_acc(const Unit& u) { return ((u.pn >> 2) & 1) == 0; }
    __device__ __forceinline__ void operator()(Acc& acc, const Unit& u, int wr, int wc, int fr, int fq) const {
        const int ty = (u.pn >> 2) & 1, pnc = u.pn & 3, pmr = u.pn >> 3;
        const int row0 = pmr * BM + wr * 64 + fr, col0 = pnc * BM + wc * 32 + 8 * fq;
        if (ty == 0) {
#pragma unroll
            for (int ai = 0; ai < 2; ++ai)
#pragma unroll
                for (int m = 0; m < 4; ++m) { const size_t off = (size_t)(row0 + ai * HALF + m * 16) * DM + col0;
#pragma unroll
                    for (int bj = 0; bj < 2; ++bj) { f32x4 g0, g1, h0, h1; unpack8(*(const v4u*)(S6 + off + bj * HALF), g0, g1); unpack8(*(const v4u*)(S7 + off + bj * HALF), h0, h1);
#pragma unroll
                        for (int j = 0; j < 4; ++j) { acc[ai][bj][m][0][j] *= g0[j] * __builtin_amdgcn_rcpf(h0[j]); acc[ai][bj][m][1][j] *= g1[j] * __builtin_amdgcn_rcpf(h1[j]); } } }
        } else {
#pragma unroll
            for (int ai = 0; ai < 2; ++ai)
#pragma unroll
                for (int m = 0; m < 4; ++m) { const size_t off = (size_t)(row0 + ai * HALF + m * 16) * DM + col0;
#pragma unroll
                    for (int bj = 0; bj < 2; ++bj) { f32x4 h0, h1; unpack8(*(const v4u*)(S7 + off + bj * HALF), h0, h1);
                        *(v4u*)(MG + off + bj * HALF) = pack8(h0 * acc[ai][bj][m][0], h1 * acc[ai][bj][m][1]); } }
        }
    }
};
struct EpiOut {
    const float* mods; bf16_t* MIX;
    static __device__ __forceinline__ bool keep_acc(const Unit&) { return false; }
    __device__ __forceinline__ void operator()(Acc& acc, const Unit& u, int wr, int wc, int fr, int fq) const {
        const int row0 = u.pm * BM + wr * 64 + fr, col0 = u.pn * BM + wc * 32 + 8 * fq, b = (u.pm * BM) >> 11;
        f32x4 g[2][2];
#pragma unroll
        for (int bj = 0; bj < 2; ++bj)
#pragma unroll
            for (int n = 0; n < 2; ++n) g[bj][n] = *(const f32x4*)(mods + (size_t)b * NMOD + 2 * DM + col0 + bj * HALF + 4 * n);
#pragma unroll
        for (int ai = 0; ai < 2; ++ai)
#pragma unroll
            for (int m = 0; m < 4; ++m) { const size_t off = (size_t)(row0 + ai * HALF + m * 16) * DM + col0;
#pragma unroll
                for (int bj = 0; bj < 2; ++bj) *(v4u*)(MIX + off + bj * HALF) = pack8(g[bj][0] * acc[ai][bj][m][0], g[bj][1] * acc[ai][bj][m][1]); }
    }
};
struct EpiSwiGLU {
    unsigned char* H;
    static __device__ __forceinline__ bool keep_acc(const Unit&) { return false; }
    __device__ __forceinline__ void operator()(Acc& acc, const Unit& u, int wr, int wc, int fr, int fq) const {
        const int row0 = u.pm * BM + wr * 64 + fr, col0 = u.pn * 128 + wc * 32 + 8 * fq;
#pragma unroll
        for (int ai = 0; ai < 2; ++ai)
#pragma unroll
            for (int m = 0; m < 4; ++m) { f32x4 o[2];
#pragma unroll
                for (int n = 0; n < 2; ++n)
#pragma unroll
                    for (int j = 0; j < 4; ++j) { const float g = acc[ai][0][m][n][j]; o[n][j] = (g * acc[ai][1][m][n][j]) * __builtin_amdgcn_rcpf(1.f + __builtin_amdgcn_exp2f(g)); }
                v2u w; w.x = pk_fp8x4(o[0][0], o[0][1], o[0][2], o[0][3]); w.y = pk_fp8x4(o[1][0], o[1][1], o[1][2], o[1][3]);
                *(v2u*)(H + (size_t)(row0 + ai * HALF + m * 16) * FH + col0) = w; }
    }
};
struct EpiDown {
    const float* gate; bf16_t* YG;
    static __device__ __forceinline__ bool keep_acc(const Unit&) { return false; }
    __device__ __forceinline__ void operator()(Acc& acc, const Unit& u, int wr, int wc, int fr, int fq) const {
        const int row0 = u.pm * BM + wr * 64 + fr, col0 = u.pn * BM + wc * 32 + 8 * fq;
#pragma unroll
        for (int ai = 0; ai < 2; ++ai)
#pragma unroll
            for (int m = 0; m < 4; ++m) { const int row = row0 + ai * HALF + m * 16; const float gt = gate[row];
#pragma unroll
                for (int bj = 0; bj < 2; ++bj) *(v4u*)(YG + (size_t)row * DM + col0 + bj * HALF) = pack8(acc[ai][bj][m][0] * gt, acc[ai][bj][m][1] * gt); }
    }
};
}

namespace att {
using s16x4 = __attribute__((ext_vector_type(4))) short;
using f32x16 = __attribute__((ext_vector_type(16))) float;
using u32x4 = __attribute__((ext_vector_type(4))) unsigned;
constexpr int NW = 8, QBLK = 32, KVBLK = 64, LD = 1024;
constexpr float SCALE = 0.125f;
constexpr float THR = 8.f;
constexpr size_t SHM_V = KVBLK * 128 * 2, SHM_K = KVBLK * 64 * 2, NSLOT = 3, SHM_ATTN = NSLOT * (SHM_V + SHM_K) + NW * 64 * 4;
#define KSWZ(row, chunk) ((row) * 128 + ((((chunk) ^ ((row) >> 1)) & 7) << 4))
#define SBAR() __builtin_amdgcn_sched_barrier(0)
#ifndef MK_ATTN_PROBE
#define MK_ATTN_PROBE -1
#endif
#define AV_NOSM(V) ((V) == 5 || (V) == 6 || (V) == 7 || (V) == 8 || (V) == 9 || (V) == 10)
#define AV_NOSTAGE(V) ((V) == 9 || (V) == 10)
#define AV_NOPV(V) ((V) == 2 || (V) == 6)
#define AV_NOQK(V) ((V) == 4 || (V) == 7)
#define AV_NOSYNC(V) ((V) == 3 || (V) == 8 || (V) == 10)
__device__ __forceinline__ int crow(int r, int hi) { return (r & 3) + 8 * (r >> 2) + 4 * hi; }
__device__ __forceinline__ unsigned cvtpk(float lo, float hi) { unsigned r; asm volatile("v_cvt_pk_bf16_f32 %0, %1, %2" : "=v"(r) : "v"(lo), "v"(hi)); return r; }

__device__ __forceinline__ void partialSM(f32x16& p0, f32x16& p1, float& m_reg, float& mn, float& alpha) {
  constexpr float C = SCALE * 1.4426950408889634f;
  float pmax = p0[0];
#pragma unroll
  for (int r = 1; r < 16; ++r) pmax = fmaxf(pmax, p0[r]);
#pragma unroll
  for (int r = 0; r < 16; ++r) pmax = fmaxf(pmax, p1[r]);
  { auto rr = __builtin_amdgcn_permlane32_swap(__float_as_uint(pmax), __float_as_uint(pmax), false, false);
    pmax = fmaxf(__uint_as_float(rr[0]), __uint_as_float(rr[1])); }
  if (__builtin_expect(__all(pmax - m_reg <= THR / SCALE), 1)) { mn = m_reg; alpha = 1.f; }
  else { mn = fmaxf(m_reg, pmax); alpha = __builtin_amdgcn_exp2f((m_reg - mn) * C); m_reg = mn; }
  float mnC = -mn * C;
#pragma unroll
  for (int r = 0; r < 16; ++r) p0[r] = fmaf(p0[r], C, mnC);
#pragma unroll
  for (int r = 0; r < 16; ++r) p1[r] = fmaf(p1[r], C, mnC);
#pragma unroll
  for (int r = 0; r < 16; ++r) p0[r] = __builtin_amdgcn_exp2f(p0[r]);
#pragma unroll
  for (int r = 0; r < 16; ++r) p1[r] = __builtin_amdgcn_exp2f(p1[r]);
}
template <int VAR> __device__ __forceinline__ void finishSM(f32x16& p0, f32x16& p1, float alpha, float& l_reg, bf16x8& pa0, bf16x8& pa1, bf16x8& pa2, bf16x8& pa3) {
  if constexpr (AV_NOSM(VAR)) { asm volatile("" : "+v"(p0), "+v"(p1)); pa0 = pa1 = pa2 = pa3 = *reinterpret_cast<bf16x8*>(&p0); return; }
  float ps = 0;
#pragma unroll
  for (int r = 0; r < 16; ++r) ps += p0[r];
#pragma unroll
  for (int r = 0; r < 16; ++r) ps += p1[r];
  { auto rr = __builtin_amdgcn_permlane32_swap(__float_as_uint(ps), __float_as_uint(ps), false, false);
    ps = __uint_as_float(rr[0]) + __uint_as_float(rr[1]); }
  l_reg = l_reg * alpha + ps;
#define PK4(P, BASE, OUT) do { unsigned a0 = cvtpk(P[BASE + 0], P[BASE + 1]), a1 = cvtpk(P[BASE + 2], P[BASE + 3]);   \
    unsigned b0 = cvtpk(P[BASE + 4], P[BASE + 5]), b1 = cvtpk(P[BASE + 6], P[BASE + 7]);                              \
    auto r0 = __builtin_amdgcn_permlane32_swap(a0, b0, false, false); auto r1 = __builtin_amdgcn_permlane32_swap(a1, b1, false, false); \
    u32x4 w = {r0[0], r1[0], r0[1], r1[1]}; OUT = *reinterpret_cast<bf16x8*>(&w); } while (0)
  PK4(p0, 0, pa0); PK4(p0, 8, pa1); PK4(p1, 0, pa2); PK4(p1, 8, pa3);
#undef PK4
}
template <int VAR> __device__ __forceinline__ void qkt(f32x16& p0, f32x16& p1, const char* Ks, const bf16x8* qr, int r32, int hi) {
  p0 = f32x16{}; p1 = f32x16{};
  if constexpr (AV_NOQK(VAR)) { asm volatile("" : "+v"(p0), "+v"(p1)); return; }
#pragma unroll
  for (int d0 = 0; d0 < 4; ++d0) { const int ch = d0 * 2 + hi;
    bf16x8 b0 = *reinterpret_cast<const bf16x8*>(Ks + KSWZ(r32, ch));
    bf16x8 b1 = *reinterpret_cast<const bf16x8*>(Ks + KSWZ(32 + r32, ch));
    p0 = __builtin_amdgcn_mfma_f32_32x32x16_bf16(b0, qr[d0], p0, 0, 0, 0);
    p1 = __builtin_amdgcn_mfma_f32_32x32x16_bf16(b1, qr[d0], p1, 0, 0, 0); }
}
__device__ __forceinline__ int v_st(int k, int c) { const int kk = (k & ~0xC) | ((k & 4) << 1) | ((k & 8) >> 1); return ((kk >> 3) * 4 + (c >> 5)) * 512 + ((kk & 7) * 32 + (c & 31)) * 2; }
__device__ __forceinline__ int v_rd_base(int lane) { return ((lane & 3) << 3) | (((lane >> 2) & 3) << 6) | (((lane >> 4) & 1) << 5) | (((lane >> 5) & 1) << 8); }
constexpr int v_rd_off(int d0, int ks, int half) { return d0 * 512 + ks * 4096 + half * 2048; }
template <int OFF> __device__ __forceinline__ s16x4 tr_read(int vb) {
  s16x4 r; asm volatile("ds_read_b64_tr_b16 %0, %1 offset:%2" : "=&v"(r) : "v"(vb), "i"(OFF) : "memory"); return r;
}
struct VFrag { s16x4 l0, h0, l1, h1, l2, h2, l3, h3; };
template <int D0> __device__ __forceinline__ void v_reads(VFrag& f, int vb) {
  f.l0 = tr_read<v_rd_off(D0, 0, 0)>(vb); f.h0 = tr_read<v_rd_off(D0, 0, 1)>(vb); f.l1 = tr_read<v_rd_off(D0, 1, 0)>(vb); f.h1 = tr_read<v_rd_off(D0, 1, 1)>(vb);
  f.l2 = tr_read<v_rd_off(D0, 2, 0)>(vb); f.h2 = tr_read<v_rd_off(D0, 2, 1)>(vb); f.l3 = tr_read<v_rd_off(D0, 3, 0)>(vb); f.h3 = tr_read<v_rd_off(D0, 3, 1)>(vb);
}
template <int VAR> __device__ __forceinline__ void pv_mma(f32x16& od, const VFrag& f, bf16x8 pa0, bf16x8 pa1, bf16x8 pa2, bf16x8 pa3) {
  if constexpr (AV_NOPV(VAR)) { asm volatile("" : "+v"(od)); return; }
#define PK(L, H) (bf16x8){L[0], L[1], L[2], L[3], H[0], H[1], H[2], H[3]}
  od = __builtin_amdgcn_mfma_f32_32x32x16_bf16(pa0, PK(f.l0, f.h0), od, 0, 0, 0);
  od = __builtin_amdgcn_mfma_f32_32x32x16_bf16(pa1, PK(f.l1, f.h1), od, 0, 0, 0);
  od = __builtin_amdgcn_mfma_f32_32x32x16_bf16(pa2, PK(f.l2, f.h2), od, 0, 0, 0);
  od = __builtin_amdgcn_mfma_f32_32x32x16_bf16(pa3, PK(f.l3, f.h3), od, 0, 0, 0);
#undef PK
}
#define LWAIT(n) do { asm volatile("s_waitcnt lgkmcnt(" #n ")" ::: "memory"); SBAR(); } while (0)
template <int VAR> __device__ __forceinline__ void pv_sm(f32x16* o, int vb, bf16x8 pa0, bf16x8 pa1, bf16x8 pa2, bf16x8 pa3, f32x16& p0, f32x16& p1, float& m_reg, float& alpha) {
  constexpr float C = SCALE * 1.4426950408889634f;
  VFrag fa, fb;
  v_reads<0>(fa, vb); v_reads<1>(fb, vb); LWAIT(8);
  pv_mma<VAR>(o[0], fa, pa0, pa1, pa2, pa3);
  if constexpr (AV_NOSM(VAR)) {
    v_reads<2>(fa, vb); LWAIT(8); pv_mma<VAR>(o[1], fb, pa0, pa1, pa2, pa3);
    v_reads<3>(fb, vb); LWAIT(8); pv_mma<VAR>(o[2], fa, pa0, pa1, pa2, pa3);
    LWAIT(0); pv_mma<VAR>(o[3], fb, pa0, pa1, pa2, pa3); alpha = 1.f; asm volatile("" : "+v"(p0), "+v"(p1)); return;
  }
  float pmax = p0[0];
#pragma unroll
  for (int r = 1; r < 16; ++r) pmax = fmaxf(pmax, p0[r]);
#pragma unroll
  for (int r = 0; r < 16; ++r) pmax = fmaxf(pmax, p1[r]);
  { auto rr = __builtin_amdgcn_permlane32_swap(__float_as_uint(pmax), __float_as_uint(pmax), false, false);
    pmax = fmaxf(__uint_as_float(rr[0]), __uint_as_float(rr[1])); }
  asm volatile("" : "+v"(pmax));
  v_reads<2>(fa, vb); LWAIT(8);
  pv_mma<VAR>(o[1], fb, pa0, pa1, pa2, pa3);
  const bool keep = __all(pmax - m_reg <= THR / SCALE);
  const float mn = keep ? m_reg : fmaxf(m_reg, pmax);
  alpha = keep ? 1.f : __builtin_amdgcn_exp2f((m_reg - mn) * C); m_reg = mn;
  const float mnC = -mn * C;
#pragma unroll
  for (int r = 0; r < 16; ++r) p0[r] = fmaf(p0[r], C, mnC);
#pragma unroll
  for (int r = 0; r < 16; ++r) p1[r] = fmaf(p1[r], C, mnC);
  asm volatile("" : "+v"(p0), "+v"(p1));
  v_reads<3>(fb, vb); LWAIT(8);
  pv_mma<VAR>(o[2], fa, pa0, pa1, pa2, pa3);
  if constexpr (VAR != 1) {
#pragma unroll
  for (int r = 0; r < 16; ++r) p0[r] = __builtin_amdgcn_exp2f(p0[r]); }
  asm volatile("" : "+v"(p0));
  LWAIT(0);
  pv_mma<VAR>(o[3], fb, pa0, pa1, pa2, pa3);
  if constexpr (VAR != 1) {
#pragma unroll
  for (int r = 0; r < 16; ++r) p1[r] = __builtin_amdgcn_exp2f(p1[r]); }
  asm volatile("" : "+v"(p1));
}
template <int VAR> __device__ __forceinline__ void pv_d0(f32x16* o, int vb, bf16x8 pa0, bf16x8 pa1, bf16x8 pa2, bf16x8 pa3) {
  VFrag fa, fb;
  v_reads<0>(fa, vb); v_reads<1>(fb, vb); LWAIT(8); pv_mma<VAR>(o[0], fa, pa0, pa1, pa2, pa3);
  v_reads<2>(fa, vb); LWAIT(8); pv_mma<VAR>(o[1], fb, pa0, pa1, pa2, pa3);
  v_reads<3>(fb, vb); LWAIT(8); pv_mma<VAR>(o[2], fa, pa0, pa1, pa2, pa3);
  LWAIT(0); pv_mma<VAR>(o[3], fb, pa0, pa1, pa2, pa3);
}
template <int VAR> __device__ __forceinline__ void attn_map(const int MAP, const bf16_t* __restrict__ Qb, const bf16_t* __restrict__ Kh, const bf16_t* __restrict__ Vh, float* O1b, bf16_t* Oab,
                                         const float* subg, float lam, int seq, char* lds) {
  const int tid = threadIdx.x, lane = tid & 63, r32 = lane & 31, hi = lane >> 5; const int wid = __builtin_amdgcn_readfirstlane(tid >> 6);
  char* V_lds = lds; char* K_lds = lds + NSLOT * SHM_V;
  float* ws = (float*)(lds + NSLOT * (SHM_V + SHM_K)) + wid * 64; float* li_l = ws; float* al_l = ws + 32;
  float m_reg = -1e30f, l_reg = 0; f32x16 o[4] = {}; bf16x8 qr[4];
  const bf16_t* Qw = Qb + (long)(wid * QBLK + r32) * LD + hi * 8;
  const bf16_t* ksrc; const bf16_t* vsrc0; const bf16_t* vsrc1;
  { const int p = wid * 64 + lane, row = p >> 3, ch = (p & 7) ^ ((row >> 1) & 7); ksrc = Kh + (long)row * LD + ch * 8; }
  { const int p = (2 * wid) * 64 + lane, sub = p >> 5, q = p & 31, kk = (sub >> 2) * 8 + (q >> 2), c = (sub & 3) * 32 + (q & 3) * 8, k = (kk & ~0xC) | ((kk & 4) << 1) | ((kk & 8) >> 1); vsrc0 = Vh + (long)k * LD + c; }
  { const int p = (2 * wid + 1) * 64 + lane, sub = p >> 5, q = p & 31, kk = (sub >> 2) * 8 + (q >> 2), c = (sub & 3) * 32 + (q & 3) * 8, k = (kk & ~0xC) | ((kk & 4) << 1) | ((kk & 8) >> 1); vsrc1 = Vh + (long)k * LD + c; }
  typedef __attribute__((address_space(3))) unsigned ldsu;
  ldsu* kdst = (ldsu*)(__attribute__((address_space(3))) char*)(K_lds) + wid * 256;
  ldsu* vdst = (ldsu*)(__attribute__((address_space(3))) char*)(V_lds) + wid * 512;
  const int NT = seq / KVBLK, TL = NT - 1;
#define DMA_K(t, slot) do { if constexpr (!AV_NOSTAGE(VAR)) { const int t_ = (t) < TL ? (t) : TL; \
    __builtin_amdgcn_global_load_lds((const unsigned*)(ksrc + (long)t_ * KVBLK * LD), kdst + (slot) * (int)(SHM_K / 4), 16, 0, 0); } } while (0)
#define DMA_V(t, slot) do { if constexpr (!AV_NOSTAGE(VAR)) { const int t_ = (t) < TL ? (t) : TL; \
    __builtin_amdgcn_global_load_lds((const unsigned*)(vsrc0 + (long)t_ * KVBLK * LD), vdst + (slot) * (int)(SHM_V / 4), 16, 0, 0); \
    __builtin_amdgcn_global_load_lds((const unsigned*)(vsrc1 + (long)t_ * KVBLK * LD), vdst + (slot) * (int)(SHM_V / 4) + 256, 16, 0, 0); } } while (0)
#define TILE_BAR(n) do { asm volatile("s_waitcnt vmcnt(" #n ") lgkmcnt(0)" ::: "memory"); if constexpr (!AV_NOSYNC(VAR)) __builtin_amdgcn_s_barrier(); asm volatile("" ::: "memory"); } while (0)
#define RESC(a) do { if (__any((a) < 1.f)) { if (hi == 0) al_l[r32] = (a); asm volatile("s_waitcnt lgkmcnt(0)" ::: "memory"); \
    _Pragma("unroll") for (int d = 0; d < 4; ++d) _Pragma("unroll") for (int r = 0; r < 16; ++r) o[d][r] *= al_l[crow(r, hi)]; } } while (0)
  DMA_K(0, 0); DMA_V(0, 0); DMA_K(1, 1);
#pragma unroll
  for (int d0 = 0; d0 < 4; ++d0) qr[d0] = *reinterpret_cast<const bf16x8*>(Qw + d0 * 16);
  const int vb0 = (int)(uintptr_t)V_lds + v_rd_base(lane);
  f32x16 pA0, pA1, pB0, pB1; float mnA, alA, alB; bf16x8 pa0, pa1, pa2, pa3;
  TILE_BAR(0);
  int kc = 0, vp = 2;
#define NEXT3(x) ((x) == 2 ? 0 : (x) + 1)
#define PREV3(x) ((x) == 0 ? 2 : (x) - 1)
  DMA_K(2, PREV3(kc)); DMA_V(1, NEXT3(NEXT3(vp)));
  qkt<VAR>(pA0, pA1, K_lds + kc * SHM_K, qr, r32, hi); partialSM(pA0, pA1, m_reg, mnA, alA);
  TILE_BAR(3); kc = NEXT3(kc); vp = NEXT3(vp);
  for (int j = 1; j + 1 < NT; j += 2) {
    DMA_K(j + 2, PREV3(kc)); DMA_V(j + 1, NEXT3(NEXT3(vp)));
    SBAR(); qkt<VAR>(pB0, pB1, K_lds + kc * SHM_K, qr, r32, hi);
    finishSM<VAR>(pA0, pA1, alA, l_reg, pa0, pa1, pa2, pa3); SBAR();
    pv_sm<VAR>(o, vb0 + vp * (int)SHM_V, pa0, pa1, pa2, pa3, pB0, pB1, m_reg, alB);
    RESC(alB); TILE_BAR(3); kc = NEXT3(kc); vp = NEXT3(vp);
    DMA_K(j + 3, PREV3(kc)); DMA_V(j + 2, NEXT3(NEXT3(vp)));
    SBAR(); qkt<VAR>(pA0, pA1, K_lds + kc * SHM_K, qr, r32, hi);
    finishSM<VAR>(pB0, pB1, alB, l_reg, pa0, pa1, pa2, pa3); SBAR();
    pv_sm<VAR>(o, vb0 + vp * (int)SHM_V, pa0, pa1, pa2, pa3, pA0, pA1, m_reg, alA);
    RESC(alA); TILE_BAR(3); kc = NEXT3(kc); vp = NEXT3(vp);
  }
  DMA_K(NT, PREV3(kc)); DMA_V(NT, NEXT3(NEXT3(vp)));
  SBAR(); qkt<VAR>(pB0, pB1, K_lds + kc * SHM_K, qr, r32, hi);
  finishSM<VAR>(pA0, pA1, alA, l_reg, pa0, pa1, pa2, pa3); SBAR();
  pv_sm<VAR>(o, vb0 + vp * (int)SHM_V, pa0, pa1, pa2, pa3, pB0, pB1, m_reg, alB);
  RESC(alB); TILE_BAR(3); vp = NEXT3(vp);
  finishSM<VAR>(pB0, pB1, alB, l_reg, pa0, pa1, pa2, pa3); SBAR();
  pv_d0<VAR>(o, vb0 + vp * (int)SHM_V, pa0, pa1, pa2, pa3);
  TILE_BAR(0);
  if (hi == 0) li_l[r32] = l_reg; asm volatile("s_waitcnt lgkmcnt(0)" ::: "memory");
  float rli[16];
#pragma unroll
  for (int r = 0; r < 16; ++r) rli[r] = __builtin_amdgcn_rcpf(li_l[crow(r, hi)]);
  int r32e = r32, hie = hi, wide = wid, lanee = lane; asm volatile("" : "+v"(r32e), "+v"(hie), "+v"(wide), "+v"(lanee));
  u32x4* o1l = (u32x4*)(lds + SHM_ATTN) + wide * 512 + lanee;
  if (MAP == 0) {
#pragma unroll
    for (int d0 = 0; d0 < 4; ++d0)
#pragma unroll
      for (int g = 0; g < 2; ++g) { u32x4 w;
#pragma unroll
        for (int q = 0; q < 4; ++q) { const int r = g * 8 + 2 * q; w[q] = cvtpk(o[d0][r] * rli[r], o[d0][r + 1] * rli[r + 1]); }
        o1l[(d0 * 2 + g) * 64] = w; }
  } else {
    float sg[4];
#pragma unroll
    for (int d0 = 0; d0 < 4; ++d0) sg[d0] = subg[d0 * 32 + r32e] * (1.f - LAM_INIT);
    bf16_t* Oa = Oab + (long)(wide * QBLK) * LD;
#pragma unroll
    for (int d0 = 0; d0 < 4; ++d0)
#pragma unroll
      for (int g = 0; g < 2; ++g) { const u32x4 w = o1l[(d0 * 2 + g) * 64];
#pragma unroll
        for (int q = 0; q < 4; ++q) { const int r = g * 8 + 2 * q;
          o[d0][r] = __uint_as_float(w[q] << 16) - lam * (o[d0][r] * rli[r]); o[d0][r + 1] = __uint_as_float(w[q] & 0xffff0000u) - lam * (o[d0][r + 1] * rli[r + 1]); } }
#pragma unroll
    for (int rg = 0; rg < 4; ++rg) {
      float ss[4];
#pragma unroll
      for (int q = 0; q < 4; ++q) { const int r = rg * 4 + q; float s_ = 0.f;
#pragma unroll
        for (int d0 = 0; d0 < 4; ++d0) s_ += o[d0][r] * o[d0][r];
        ss[q] = s_; }
#pragma unroll
      for (int sft = 1; sft < 32; sft <<= 1)
#pragma unroll
        for (int q = 0; q < 4; ++q) ss[q] += __shfl_xor(ss[q], sft);
#pragma unroll
      for (int q = 0; q < 4; ++q) { const int r = rg * 4 + q, orow = crow(r, hie); const float rs = __builtin_amdgcn_rsqf(ss[q] * (1.f / 128.f) + EPS);
#pragma unroll
        for (int d0 = 0; d0 < 4; ++d0) Oa[(long)orow * LD + d0 * 32 + r32e] = (bf16_t)f2bf(o[d0][r] * rs * sg[d0]); }
    }
  }
#undef DMA_K
#undef DMA_V
#undef TILE_BAR
#undef NEXT3
#undef PREV3
#undef RESC
}
#undef SBAR
}

constexpr int CW_TMO = 0, CW_CODE = 1;
constexpr int CW_BAR = 4096;
#define XB_TMO      128
#define XB_XCNT(j)  (256  + 64 * (j))
#define XB_XSUB(j)  (1280 + 64 * (j))
#define XB_XGEN(j)  (2304 + 64 * (j))
#define XB_TOP      3328
#define XB_TOPGEN   3392
#define XCD_BAR_WORDS 3456
#define XB_SPIN_CAP (1u << 18)
__device__ __forceinline__ unsigned xb_ld(unsigned* p)              { return __hip_atomic_load(p, __ATOMIC_RELAXED, __HIP_MEMORY_SCOPE_AGENT); }
__device__ __forceinline__ unsigned xb_add(unsigned* p, unsigned v) { return __hip_atomic_fetch_add(p, v, __ATOMIC_RELAXED, __HIP_MEMORY_SCOPE_AGENT); }
__device__ __forceinline__ unsigned xb_xcc_id() { return (unsigned)__builtin_amdgcn_s_getreg((3 << 11) | 20) & 0xFu; }
#define XB_SPIN(cond, bar) do { unsigned _sp = 0; while (cond) { __builtin_amdgcn_s_sleep(1); \
    if ((++_sp & 255u) == 0u) { if (xb_ld(&(bar)[XB_TMO])) break; if (_sp > XB_SPIN_CAP) { atomicAdd(&(bar)[XB_TMO], 1u); break; } } } } while (0)
struct XcdBarrier { unsigned* bar; unsigned x; volatile LAS unsigned* st; };
__device__ __forceinline__ XcdBarrier xcd_barrier_post(unsigned* bar, volatile LAS unsigned* st) {
    XcdBarrier b; b.bar = bar; b.x = xb_xcc_id(); b.st = st;
    if (threadIdx.x == 0) (void)xb_add(&bar[XB_XCNT(b.x)], 1u);
    return b;
}
__device__ __forceinline__ void xcd_barrier_complete(unsigned* bar, unsigned x, unsigned& nloc, unsigned& nx) {
    const unsigned G = gridDim.x * gridDim.y * gridDim.z;
    unsigned sum, cnt, mine, sp = 0u;
    for (;;) {
        sum = 0u; cnt = 0u; mine = 0u;
#pragma unroll
        for (unsigned j = 0; j < 16; ++j) { const unsigned c = xb_ld(&bar[XB_XCNT(j)]); sum += c; cnt += (c > 0u) ? 1u : 0u; mine = (j == x) ? c : mine; }
        if (sum == G) break;
        __builtin_amdgcn_s_sleep(1);
        if ((++sp & 255u) == 0u) { if (xb_ld(&bar[XB_TMO])) break; if (sp > XB_SPIN_CAP) { atomicAdd(&bar[XB_TMO], 1u); break; } }
    }
    nloc = mine > 0u ? mine : 1u; nx = cnt > 0u ? cnt : 1u;
}
__device__ __forceinline__ void xcd_barrier(const XcdBarrier& b) {
    asm volatile("s_waitcnt vmcnt(0)" ::: "memory");
    __syncthreads();
    if (threadIdx.x == 0) {
        unsigned* bar = b.bar;
        __builtin_amdgcn_s_waitcnt(0);
        unsigned nloc = b.st[0], nx = b.st[1];
        if (nloc == 0u) { xcd_barrier_complete(bar, b.x, nloc, nx); b.st[0] = nloc; b.st[1] = nx; }
        const unsigned old = xb_add(&bar[XB_XSUB(b.x)], 1u);
        __builtin_amdgcn_fence(__ATOMIC_ACQUIRE, "agent");
        const unsigned gen = old / nloc;
        if (old + 1u == (gen + 1u) * nloc) {
            __builtin_amdgcn_fence(__ATOMIC_RELEASE, "agent");
            asm volatile("s_waitcnt vmcnt(0)" ::: "memory");
            const unsigned og = xb_add(&bar[XB_TOP], 1u);
            const unsigned tg = og / nx;
            if (og + 1u == (tg + 1u) * nx) xb_add(&bar[XB_TOPGEN], 1u);
            else XB_SPIN(xb_ld(&bar[XB_TOPGEN]) == tg, bar);
            xb_add(&bar[XB_XGEN(b.x)], 1u);
            asm volatile("s_waitcnt vmcnt(0)" ::: "memory");
        } else {
            XB_SPIN(xb_ld(&bar[XB_XGEN(b.x)]) == gen, bar);
            asm volatile("s_waitcnt vmcnt(0)" ::: "memory");
        }
    }
    __syncthreads();
}

constexpr int NWAVES = 8;
struct Args { const float* in[23]; float* out; unsigned char* ws; int ph_lo, ph_hi, li, pad; };
struct Frame {
    LAS unsigned char* lds;
    int tid, lane, wave, vcu, G;
    unsigned char* ws;
};

__device__ __forceinline__ void transpose_item(const float* W, int K, int N, bf16_t* WT, int k0, int n0, int rowbase, LAS float* scr, int lane) {
    float tv[32];
    const float* wp = W + (size_t)(k0 + (lane >> 5)) * N + n0 + (lane & 31);
#pragma unroll
    for (int i = 0; i < 32; ++i) tv[i] = __builtin_nontemporal_load(wp + (size_t)(2 * i) * N);
#pragma unroll
    for (int i = 0; i < 32; ++i) scr[(2 * i + (lane >> 5)) * 33 + (lane & 31)] = tv[i];
    LDS_WAIT(); asm volatile("" ::: "memory");
    const int c = lane & 7;
#pragma unroll
    for (int j = 0; j < 4; ++j) { const int n = (lane >> 3) + 8 * j; const LAS float* s = scr + (8 * c) * 33 + n;
        v4u o; o.x = pk2(s[0 * 33], s[1 * 33]); o.y = pk2(s[2 * 33], s[3 * 33]); o.z = pk2(s[4 * 33], s[5 * 33]); o.w = pk2(s[6 * 33], s[7 * 33]);
        *(GAS v4u*)(WT + (size_t)(rowbase + n) * K + k0 + 8 * c) = o; }
    LDS_WAIT(); asm volatile("" ::: "memory");
}

constexpr int FP8_SCR_STRIDE = 128 * 33 * 4;
__device__ __forceinline__ void transpose_item_fp8(const float* W, int K, int N, unsigned char* WT, int k0, int n0, int rowbase, LAS float* scr, int lane, const float wsc = 16.f) {
    const float* wp = W + (size_t)(k0 + (lane >> 5)) * N + n0 + (lane & 31);
    { float tv[64];
#pragma unroll
        for (int i = 0; i < 64; ++i) tv[i] = __builtin_nontemporal_load(wp + (size_t)(2 * i) * N);
#pragma unroll
        for (int i = 0; i < 64; ++i) scr[(2 * i + (lane >> 5)) * 33 + (lane & 31)] = tv[i]; }
    LDS_WAIT(); asm volatile("" ::: "memory");
    const int c = lane & 7;
#pragma unroll
    for (int j = 0; j < 4; ++j) { const int n = (lane >> 3) + 8 * j; const LAS float* s = scr + (16 * c) * 33 + n;
        v4u o;
#pragma unroll
        for (int q = 0; q < 4; ++q) o[q] = pk_fp8x4(wsc * s[(4 * q) * 33], wsc * s[(4 * q + 1) * 33], wsc * s[(4 * q + 2) * 33], wsc * s[(4 * q + 3) * 33]);
        *(GAS v4u*)(WT + (size_t)(rowbase + n) * K + k0 + 16 * c) = o; }
    LDS_WAIT(); asm volatile("" ::: "memory");
}
__device__ __forceinline__ void p0_prologue(Frame& F, const Args& a) {
    float* mods = (float*)(F.ws + WS_MODS);
    for (int item = blockIdx.x; item < NMOD / 64; item += F.G) {
        LAS float* sil = (LAS float*)F.lds; LAS float* red = sil + 9 * DM;
        for (int i = F.tid; i < 9 * DM; i += 512) { const float v = i < 8 * DM ? a.in[1][i] : a.in[3][i - 8 * DM]; sil[i] = v * sigmoidf_(v); }
        __syncthreads();
        const float* wa = a.in[6] + 64 * item + F.lane; float acc[9];
#pragma unroll
        for (int b = 0; b < 9; ++b) acc[b] = 0.f;
        const int kb = F.wave * 128;
#pragma unroll 8
        for (int k = kb; k < kb + 128; ++k) { const float wv = wa[(size_t)k * NMOD];
#pragma unroll
            for (int b = 0; b < 9; ++b) acc[b] += sil[b * DM + k] * wv; }
#pragma unroll
        for (int b = 0; b < 9; ++b) red[(F.wave * 9 + b) * 64 + F.lane] = acc[b];
        __syncthreads();
        for (int i = F.tid; i < 9 * 64; i += 512) { const int b = i >> 6, l = i & 63; float s = 0.f;
#pragma unroll
            for (int w = 0; w < 8; ++w) s += red[(w * 9 + b) * 64 + l];
            mods[(size_t)b * NMOD + 64 * item + l] = s + a.in[7][64 * item + l]; }
        __syncthreads();
    }
    LAS float* scr = (LAS float*)(F.lds + F.wave * 16384);
    const int gw = F.vcu * NWAVES + F.wave, NGW = F.G * NWAVES;
    constexpr int I_IN = (DM / 64) * (8 * DM / 32), I_SQ = (DM / 64) * (DM / 32);
    for (int it = gw; it < I_IN + 3 * I_SQ; it += NGW) {
        if (it < I_IN) { const int nblk = 8 * DM / 32, kb = it / nblk, nb = it % nblk, c0 = 32 * nb, part = c0 >> 10, j0 = c0 & 1023;
            const int rb = part == 0 ? (j0 >> 7) * 256 + (j0 & 127) : part == 2 ? (j0 >> 7) * 256 + 128 + (j0 & 127) : part == 1 ? 2048 + j0 : c0;
            transpose_item(a.in[8], DM, 8 * DM, (bf16_t*)(F.ws + WS_WIN), 64 * kb, c0, rb, scr, F.lane); }
        else { const int r = it - I_IN, which = r / I_SQ, q = r % I_SQ, kb = q / 32, nb = q % 32;
            const float* W = which == 0 ? a.in[10] : which == 1 ? a.in[16] : a.in[17];
            bf16_t* WT = (bf16_t*)(F.ws + (which == 0 ? WS_WC : which == 1 ? WS_WO : WS_WOUT));
            transpose_item(W, DM, DM, WT, 64 * kb, 32 * nb, 32 * nb, scr, F.lane); }
    }
}
__device__ __forceinline__ void p1_norm(Frame& F, const Args& a) {
    const float* mods = (const float*)(F.ws + WS_MODS); bf16_t* A1 = (bf16_t*)(F.ws + WS_A1);
    const int gw = F.vcu * NWAVES + F.wave, NGW = F.G * NWAVES;
    for (int row = gw; row < MA; row += NGW) {
        const float* xr = row < MX ? a.in[0] + (size_t)row * DM : a.in[2] + (size_t)(row - MX) * DM;
        const int b = row < MX ? row >> 11 : 8;
        const f32x4* xv = (const f32x4*)xr + F.lane; f32x4 v[4]; float s = 0.f;
#pragma unroll
        for (int j = 0; j < 4; ++j) { v[j] = xv[64 * j]; s += (v[j].x * v[j].x + v[j].y * v[j].y) + (v[j].z * v[j].z + v[j].w * v[j].w); }
        const float rstd = __builtin_amdgcn_rsqf(wave_sum(s) * (1.f / DM) + EPS);
        const f32x4* gv = (const f32x4*)a.in[4] + F.lane; const f32x4* shv = (const f32x4*)(mods + (size_t)b * NMOD) + F.lane; const f32x4* scv = (const f32x4*)(mods + (size_t)b * NMOD + DM) + F.lane;
        v2u* o8 = (v2u*)(A1 + (size_t)row * DM) + F.lane;
#pragma unroll
        for (int j = 0; j < 4; ++j) { const f32x4 y = (v[j] * rstd * gv[64 * j]) * (scv[64 * j] + 1.f) + shv[64 * j];
            v2u w; w.x = pk2(y.x, y.y); w.y = pk2(y.z, y.w); o8[64 * j] = w; }
    }
}
__device__ __forceinline__ void p3_conv(Frame& F, const Args& a) {
    const bf16_t* Z = (const bf16_t*)(F.ws + WS_Z); const bf16_t* GB = (const bf16_t*)(F.ws + WS_GB); bf16_t* AC = (bf16_t*)(F.ws + WS_A1);
    const int gw = F.vcu * NWAVES + F.wave, NGW = F.G * NWAVES;
    const float* cw = a.in[9];
    for (int grp = gw; grp < MX / 8; grp += NGW) {
#pragma unroll
        for (int half = 0; half < 2; ++half) {
            const int col = half * 512 + F.lane * 8;
            f32x4 w0[2], w1[2], w2[2];
#pragma unroll
            for (int i = 0; i < 2; ++i) { w0[i] = *(const f32x4*)(cw + col + 4 * i); w1[i] = *(const f32x4*)(cw + DM + col + 4 * i); w2[i] = *(const f32x4*)(cw + 2 * DM + col + 4 * i); }
            const int r0 = grp * 8; f32x4 zp[2], zc[2], zn[2];
            if ((r0 & (SEQ - 1)) == 0) { zp[0] = (f32x4){0.f, 0.f, 0.f, 0.f}; zp[1] = zp[0]; } else pg8::unpack8(*(const v4u*)(Z + (size_t)(r0 - 1) * DM + col), zp[0], zp[1]);
            pg8::unpack8(*(const v4u*)(Z + (size_t)r0 * DM + col), zc[0], zc[1]);
#pragma unroll
            for (int r = 0; r < 8; ++r) { const int row = r0 + r;
                if ((row & (SEQ - 1)) == SEQ - 1) { zn[0] = (f32x4){0.f, 0.f, 0.f, 0.f}; zn[1] = zn[0]; } else pg8::unpack8(*(const v4u*)(Z + (size_t)(row + 1) * DM + col), zn[0], zn[1]);
                f32x4 g0, g1; pg8::unpack8(*(const v4u*)(GB + (size_t)row * DM + col), g0, g1);
                const f32x4 y0 = g0 * (zp[0] * w0[0] + zc[0] * w1[0] + zn[0] * w2[0]), y1 = g1 * (zp[1] * w0[1] + zc[1] * w1[1] + zn[1] * w2[1]);
                *(v4u*)(AC + (size_t)row * DM + col) = pg8::pack8(y0, y1);
                zp[0] = zc[0]; zp[1] = zc[1]; zc[0] = zn[0]; zc[1] = zn[1]; }
        }
    }
}
template <int VAR> __device__ __forceinline__ void p3_attn(Frame& F, const Args& a, char* lds) {
    float s1 = 0.f, s2 = 0.f;
    for (int i = 0; i < 64; ++i) { s1 += a.in[11][i] * a.in[12][i]; s2 += a.in[13][i] * a.in[14][i]; }
    const float lam = __expf(s1) - __expf(s2) + LAM_INIT;
    const bf16_t* Q = (const bf16_t*)(F.ws + WS_Q); const bf16_t* KA = (const bf16_t*)(F.ws + WS_KALL); const bf16_t* VA = (const bf16_t*)(F.ws + WS_VALL);
    float* O1 = (float*)(F.ws + WS_O1); bf16_t* OA = (bf16_t*)(F.ws + (VAR < 0 ? WS_OATT : WS_MERGED));
    for (int it = 2 * F.vcu; it < 2 * NB * NH * 8; it += 2 * F.G + ((it & 1) ? -1 : 1) - ((it & 1) ? 0 : 2 * F.G)) {
        const int u = it >> 1, map = it & 1;
        const int bh = u >> 3, qb = u & 7, b = bh >> 3, h = bh & 7;
        const size_t qrow = (size_t)b * SEQ + qb * 256, krow = (size_t)b * SKV;
        att::attn_map<VAR>(map, Q + qrow * DM + h * 128 + map * 64, KA + krow * DM + h * 128 + map * 64, VA + krow * DM + h * 128, O1 + qrow * DM + h * 128, OA + qrow * DM + h * 128, a.in[15], lam, SKV, lds);
    }
}
__device__ __forceinline__ void p6_norm_router(Frame& F, const Args& a) {
    const float* mods = (const float*)(F.ws + WS_MODS); unsigned char* HX = (unsigned char*)(F.ws + WS_HX2);   float* aff = (float*)(F.ws + WS_AFF);
    LAS float* wrT = (LAS float*)F.lds;
    for (int i = F.tid; i < DM * NE; i += 512) wrT[(i & 15) * DM + (i >> 4)] = a.in[18][i];
    __syncthreads();
    const int gw = F.vcu * NWAVES + F.wave, NGW = F.G * NWAVES;
    const f32x4* gv = (const f32x4*)a.in[5] + F.lane;
    const bool b5 = F.lane & 32, b4 = F.lane & 16, b3 = F.lane & 8, b2 = F.lane & 4;
    for (int grp = gw; grp < MX / 8; grp += NGW) {
        const int b = (grp * 8) >> 11;
        const f32x4* shv = (const f32x4*)(mods + (size_t)b * NMOD + 3 * DM) + F.lane; const f32x4* scv = (const f32x4*)(mods + (size_t)b * NMOD + 4 * DM) + F.lane; f32x4 sh[4], sc[4];
#pragma unroll
        for (int j = 0; j < 4; ++j) { sh[j] = shv[64 * j]; sc[j] = (scv[64 * j] + 1.f) * gv[64 * j]; }
        const bf16_t* MIX = (const bf16_t*)(F.ws + WS_MIX);
        f32x4 vn[2][4]; v2u mn_[2][4];
#pragma unroll
        for (int t = 0; t < 2; ++t) { const f32x4* xv = (const f32x4*)(a.in[0] + (size_t)(grp * 8 + t) * DM) + F.lane; const v2u* mv = (const v2u*)(MIX + (size_t)(grp * 8 + t) * DM) + F.lane;
#pragma unroll
          for (int j = 0; j < 4; ++j) { vn[t][j] = xv[64 * j]; mn_[t][j] = mv[64 * j]; } }
#pragma unroll 1
        for (int rp = 0; rp < 4; ++rp) { const int row = grp * 8 + 2 * rp;
            f32x4 v[2][4]; float s[2] = {0.f, 0.f};
#pragma unroll
            for (int t = 0; t < 2; ++t)
#pragma unroll
                for (int j = 0; j < 4; ++j) { v[t][j] = vn[t][j] + (f32x4){bf_lo(mn_[t][j].x), bf_hi(mn_[t][j].x), bf_lo(mn_[t][j].y), bf_hi(mn_[t][j].y)};
                    s[t] += (v[t][j].x * v[t][j].x + v[t][j].y * v[t][j].y) + (v[t][j].z * v[t][j].z + v[t][j].w * v[t][j].w); }
            if (rp < 3) {
#pragma unroll
                for (int t = 0; t < 2; ++t) { const f32x4* xv = (const f32x4*)(a.in[0] + (size_t)(row + 2 + t) * DM) + F.lane; const v2u* mv = (const v2u*)(MIX + (size_t)(row + 2 + t) * DM) + F.lane;
#pragma unroll
                    for (int j = 0; j < 4; ++j) { vn[t][j] = xv[64 * j]; mn_[t][j] = mv[64 * j]; } } }
#pragma unroll
            for (int t = 0; t < 2; ++t) { const float rstd = __builtin_amdgcn_rsqf(wave_sum(s[t]) * (1.f / DM) + EPS);
                unsigned* o8 = (unsigned*)(HX + (size_t)(row + t) * DM) + F.lane;
#pragma unroll
                for (int j = 0; j < 4; ++j) { v[t][j] = (v[t][j] * rstd) * sc[j] + sh[j];
                    o8[64 * j] = pk_fp8x4(v[t][j].x, v[t][j].y, v[t][j].z, v[t][j].w); } }
            f32x2 vv[16];
#pragma unroll
            for (int j = 0; j < 4; ++j)
#pragma unroll
                for (int c = 0; c < 4; ++c) vv[4 * j + c] = (f32x2){v[0][j][c], v[1][j][c]};
            float p[2][NE];
#pragma unroll
            for (int eg = 0; eg < NE; eg += 2) {
#pragma unroll
                for (int e = eg; e < eg + 2; ++e) { f32x2 q = {0.f, 0.f};
#pragma unroll
                    for (int j = 0; j < 4; ++j) { const f32x4 w = *(const LAS f32x4*)(wrT + e * DM + 256 * j + 4 * F.lane);
#pragma unroll
                        for (int c = 0; c < 4; ++c) q = __builtin_elementwise_fma(vv[4 * j + c], (f32x2){w[c], w[c]}, q); }
                    p[0][e] = q.x; p[1][e] = q.y; }
                asm volatile("" ::: "memory"); }
#pragma unroll
            for (int t = 0; t < 2; ++t) {
                float q8[8], q4[4], q2[2], q1;
#pragma unroll
                for (int i = 0; i < 8; ++i) { const float keep = b5 ? p[t][i + 8] : p[t][i], send = b5 ? p[t][i] : p[t][i + 8]; q8[i] = keep + __shfl_xor(send, 32); }
#pragma unroll
                for (int i = 0; i < 4; ++i) { const float keep = b4 ? q8[i + 4] : q8[i], send = b4 ? q8[i] : q8[i + 4]; q4[i] = keep + __shfl_xor(send, 16); }
#pragma unroll
                for (int i = 0; i < 2; ++i) { const float keep = b3 ? q4[i + 2] : q4[i], send = b3 ? q4[i] : q4[i + 2]; q2[i] = keep + __shfl_xor(send, 8); }
                { const float keep = b2 ? q2[1] : q2[0], send = b2 ? q2[0] : q2[1]; q1 = keep + __shfl_xor(send, 4); }
                q1 += __shfl_xor(q1, 1); q1 += __shfl_xor(q1, 2);
                float mx = q1;
#pragma unroll
                for (int sft = 4; sft < 64; sft <<= 1) mx = fmaxf(mx, __shfl_xor(mx, sft));
                const float ex = __expf(q1 - mx); float den = ex;
#pragma unroll
                for (int sft = 4; sft < 64; sft <<= 1) den += __shfl_xor(den, sft);
                if ((F.lane & 3) == 0) aff[(size_t)(row + t) * NE + (F.lane >> 2)] = ex / den;
            }
        }
    }
    __syncthreads();
}
__device__ __forceinline__ void p7_topk_item(Frame& F, int item) {
    const int b = item >> 4, e = item & 15;
    const float* aff = (const float*)(F.ws + WS_AFF); int* slot = (int*)(F.ws + WS_SLOT); float* gate = (float*)(F.ws + WS_GATE);
    LAS unsigned long long* key = (LAS unsigned long long*)F.lds;
    LAS int* sel = (LAS int*)(F.lds + 16384);
    for (int i = F.tid; i < SEQ; i += 512) { const float v = aff[((size_t)b * SEQ + i) * NE + e];
        key[i] = ((unsigned long long)__builtin_bit_cast(unsigned, v) << 32) | (unsigned)(SEQ - 1 - i); sel[i] = -1; }
    __syncthreads();
    for (int k = 2; k <= SEQ; k <<= 1)
        for (int j = k >> 1; j > 0; j >>= 1) {
            for (int t = F.tid; t < SEQ / 2; t += 512) { const int i = ((t & ~(j - 1)) << 1) | (t & (j - 1)), p = i | j;
                const unsigned long long x = key[i], y = key[p]; const bool desc = (i & k) == 0;
                if (desc ? (x < y) : (x > y)) { key[i] = y; key[p] = x; } }
            __syncthreads();
        }
    const int xsrow0 = (e * NB + b) * CAP; int* gidx = (int*)(F.ws + WS_GIDX);
    if (F.tid < CAP) { const unsigned long long kk = key[F.tid]; const int idx = SEQ - 1 - (int)(unsigned)kk; sel[idx] = F.tid; gate[xsrow0 + F.tid] = __builtin_bit_cast(float, (unsigned)(kk >> 32)); gidx[xsrow0 + F.tid] = b * SEQ + idx; }
    __syncthreads();
    for (int i = F.tid; i < SEQ; i += 512) slot[(size_t)(b * NE + e) * SEQ + i] = sel[i];
    __syncthreads();
}
constexpr int N_WGU_ITEMS = NE * 1024, N_WD_ITEMS = NE * 512, WD_EARLY_PER_WAVE = 3, WD_EARLY = 192 * NWAVES * WD_EARLY_PER_WAVE;
__device__ __forceinline__ void moe_item_desc(Frame& F, const Args& a, int it, int wd0, const float*& wp, unsigned char*& op, int& N, int& K, float& wsc) {
    const float* W; unsigned char* WT; int k0, n0, rowbase;
    if (it < N_WGU_ITEMS) { const int e = it >> 10, r = it & 1023, which = r >> 9, q = r & 511, kb = q >> 6, nb = q & 63; n0 = 32 * nb; k0 = 128 * kb;
        W = (which == 0 ? a.in[19] : a.in[20]) + (size_t)e * DM * FH; K = DM; N = FH; WT = (unsigned char*)(F.ws + WS_WGU); rowbase = e * 4096 + (n0 >> 7) * 256 + (n0 & 127) + which * 128;
        wsc = which == 0 ? -16.f * 1.4426950408889634f : -16.f / 1.4426950408889634f; }
    else { const int w = wd0 + (it - N_WGU_ITEMS), e = w >> 9, q = w & 511, kb = q >> 5, nb = q & 31; n0 = 32 * nb; k0 = 128 * kb;
        W = a.in[21] + (size_t)e * FH * DM; K = FH; N = DM; WT = (unsigned char*)(F.ws + WS_WD); rowbase = e * DM + n0; wsc = 16.f; }
    wp = W + (size_t)(k0 + (F.lane >> 5)) * N + n0 + (F.lane & 31); op = WT + (size_t)rowbase * K + k0;
}
__device__ __forceinline__ void moe_item_load(float (&tv)[64], const float* wp, int N) {
#pragma unroll
    for (int i = 0; i < 64; ++i) tv[i] = __builtin_nontemporal_load(wp + (size_t)(2 * i) * N);
}
__device__ __forceinline__ void moe_item_finish(const float (&tv)[64], unsigned char* op, int K, float wsc, LAS float* scr, int lane) {
#pragma unroll
    for (int i = 0; i < 64; ++i) scr[(2 * i + (lane >> 5)) * 33 + (lane & 31)] = tv[i];
    LDS_WAIT(); asm volatile("" ::: "memory");
    const int c = lane & 7;
#pragma unroll
    for (int j = 0; j < 4; ++j) { const int n = (lane >> 3) + 8 * j; const LAS float* s = scr + (16 * c) * 33 + n;
        v4u o;
#pragma unroll
        for (int q = 0; q < 4; ++q) o[q] = pk_fp8x4(wsc * s[(4 * q) * 33], wsc * s[(4 * q + 1) * 33], wsc * s[(4 * q + 2) * 33], wsc * s[(4 * q + 3) * 33]);
        *(GAS v4u*)(op + (size_t)n * K + 16 * c) = o; }
    LDS_WAIT(); asm volatile("" ::: "memory");
}
__device__ __forceinline__ void moe_convert_items(Frame& F, const Args& a, int start, int step, int end, int wd0, LAS float* scr) {
    if (start >= end) return;
    float ta[64], tb[64]; const float* wpa; unsigned char* opa; int Na, Ka; float wsa; const float* wpb = nullptr; unsigned char* opb = nullptr; int Nb = 0, Kb = 0; float wsb = 0.f;
    moe_item_desc(F, a, start, wd0, wpa, opa, Na, Ka, wsa);
    moe_item_load(ta, wpa, Na);
#pragma unroll 1
    for (int it = start; it < end; it += 2 * step) {
        const bool hb = it + step < end;
        if (hb) { moe_item_desc(F, a, it + step, wd0, wpb, opb, Nb, Kb, wsb); moe_item_load(tb, wpb, Nb); }
        moe_item_finish(ta, opa, Ka, wsa, scr, F.lane);
        if (hb) { if (it + 2 * step < end) { moe_item_desc(F, a, it + 2 * step, wd0, wpa, opa, Na, Ka, wsa); moe_item_load(ta, wpa, Na); }
            moe_item_finish(tb, opb, Kb, wsb, scr, F.lane); }
    }
}
constexpr int NIT7 = N_WGU_ITEMS + N_WD_ITEMS - WD_EARLY, Y3 = 6, N3 = 256 * NWAVES * Y3, X7 = 8;
static_assert(N3 <= NIT7 && N3 + 128 * NWAVES * X7 >= NIT7, "MoE weight item split");
__device__ __forceinline__ void p3_weight_share(Frame& F, const Args& a) {
    if (F.G != 256) return;
    LAS float* scr = (LAS float*)(F.lds + F.wave * FP8_SCR_STRIDE);
    const int start = F.vcu * NWAVES * Y3 + F.wave;
    moe_convert_items(F, a, start, NWAVES, start + NWAVES * Y3, WD_EARLY, scr);
}
__device__ __forceinline__ void p7_topk_weights(Frame& F, const Args& a) {
    LAS float* scr = (LAS float*)(F.lds + F.wave * FP8_SCR_STRIDE);
    if (F.G == 256) {
        if (!(F.vcu & 1)) p7_topk_item(F, F.vcu >> 1);
        else { const int start = N3 + (F.vcu >> 1) * NWAVES * X7 + F.wave;
            moe_convert_items(F, a, start, NWAVES, min(start + NWAVES * X7, NIT7), WD_EARLY, scr); }
    } else {
        for (int item = F.vcu; item < NB * NE; item += F.G) p7_topk_item(F, item);
        const int gw = F.vcu * NWAVES + F.wave, NGW = F.G * NWAVES;
        moe_convert_items(F, a, gw, NGW, N_WGU_ITEMS + N_WD_ITEMS, 0, scr);
    }
}
template <bool DRY> __device__ __forceinline__ void p10_final(Frame& F, const Args& a) {
    const float* mods = (const float*)(F.ws + WS_MODS); const int* slot = (const int*)(F.ws + WS_SLOT); const bf16_t* YG = (const bf16_t*)(F.ws + WS_YG);
    const int gw = F.vcu * NWAVES + F.wave, NGW = F.G * NWAVES;
    const f32x4* fgv = (const f32x4*)a.in[22] + F.lane; f32x4 fg[4];
#pragma unroll
    for (int j = 0; j < 4; ++j) fg[j] = fgv[64 * j];
    for (int grp = gw; grp < MX / 8; grp += NGW) {
        const int row0 = grp * 8, b = row0 >> 11, t0 = row0 & (SEQ - 1);
        const f32x4* g2v = (const f32x4*)(mods + (size_t)b * NMOD + 5 * DM) + F.lane; f32x4 g2[4];
#pragma unroll
        for (int j = 0; j < 4; ++j) g2[j] = g2v[64 * j];
        const int sl0 = slot[(size_t)(b * NE + (F.lane & 15)) * SEQ + t0 + (F.lane >> 4)], sl1 = slot[(size_t)(b * NE + (F.lane & 15)) * SEQ + t0 + 4 + (F.lane >> 4)];
#pragma unroll 2
        for (int r = 0; r < 8; ++r) { const int row = row0 + r;
            const int sv = r < 4 ? sl0 : sl1;
            unsigned long long bal = __ballot(sv >= 0); unsigned mask = (unsigned)(bal >> (16 * (r & 3))) & 0xffffu;
            f32x4 acc[4];
#pragma unroll
            for (int j = 0; j < 4; ++j) acc[j] = (f32x4){0.f, 0.f, 0.f, 0.f};
            while (mask) {
                const v2u* yv[4]; float wgt[4];
#pragma unroll
                for (int i = 0; i < 4; ++i) { int e = 0, sidx = 0; wgt[i] = 0.f;
                    if (mask) { e = __builtin_ctz(mask); mask &= mask - 1; sidx = __builtin_amdgcn_readlane(sv, 16 * (r & 3) + e); wgt[i] = 1.f; }
                    yv[i] = (const v2u*)(YG + (size_t)((e * NB + b) * CAP + sidx) * DM) + F.lane; }
                v2u w[4][4];
#pragma unroll
                for (int i = 0; i < 4; ++i)
#pragma unroll
                    for (int j = 0; j < 4; ++j) w[i][j] = yv[i][64 * j];
#pragma unroll
                for (int i = 0; i < 4; ++i)
#pragma unroll
                    for (int j = 0; j < 4; ++j) acc[j] += (f32x4){bf_lo(w[i][j].x), bf_hi(w[i][j].x), bf_lo(w[i][j].y), bf_hi(w[i][j].y)} * wgt[i];
            }
            const f32x4* xin = (const f32x4*)(a.in[0] + (size_t)row * DM) + F.lane; const v2u* mv = (const v2u*)((const bf16_t*)(F.ws + WS_MIX) + (size_t)row * DM) + F.lane;
            f32x4* xv = (f32x4*)(a.out + (size_t)row * DM) + F.lane; f32x4 v[4]; float s = 0.f;
#pragma unroll
            for (int j = 0; j < 4; ++j) { const v2u mw = mv[64 * j]; v[j] = (xin[64 * j] + (f32x4){bf_lo(mw.x), bf_hi(mw.x), bf_lo(mw.y), bf_hi(mw.y)}) + g2[j] * acc[j]; s += (v[j].x * v[j].x + v[j].y * v[j].y) + (v[j].z * v[j].z + v[j].w * v[j].w); }
            const float rstd = __builtin_amdgcn_rsqf(wave_sum(s) * (1.f / DM) + EPS);
#pragma unroll
            for (int j = 0; j < 4; ++j) (DRY ? (f32x4*)((float*)(F.ws + WS_O1) + (size_t)row * DM) + F.lane : xv)[64 * j] = v[j] * rstd * fg[j];
        }
    }
}

__global__ void __launch_bounds__(NWAVES * 64, 2) mk_fwd(Args args) {
    extern __shared__ __attribute__((aligned(16))) unsigned char lds[];
    Frame F;
    F.lds = (LAS unsigned char*)lds;
    F.tid = threadIdx.x; F.lane = F.tid & 63; F.wave = __builtin_amdgcn_readfirstlane(F.tid >> 6);
    F.G = gridDim.x; { const int bx = blockIdx.x; F.vcu = (F.G % 8 == 0) ? (bx % 8) * (F.G / 8) + bx / 8 : bx; }
    F.ws = args.ws;
    volatile LAS unsigned* MISC = (volatile LAS unsigned*)(F.lds + MISC_OFF);
    gu32* ctl = (gu32*)(F.ws + WS_CTL);
    for (int u = F.tid; u < (LDS_BYTES - LDSCTL_OFF) / 4; u += NWAVES * 64) ((LAS unsigned*)(F.lds + LDSCTL_OFF))[u] = 0u;
    {
        LAS float* rope = (LAS float*)(F.lds + ROPE_OFF);
        for (int i = F.tid; i < 64 * 16; i += NWAVES * 64) { const int pos = i >> 4, f = i & 15;
            const float inv = __builtin_amdgcn_exp2f(-(float)f * (13.287712379549449f / 16.f)); const float ang = (float)pos * inv;
            rope[2 * i] = cosf(ang); rope[2 * i + 1] = sinf(ang); }
    }
    __syncthreads();
    const int lo = args.ph_lo, hi = args.ph_hi;
    XcdBarrier bar; bar.bar = (unsigned*)(ctl + CW_BAR) + args.li * XCD_BAR_WORDS; bar.x = 0; bar.st = nullptr;
    if (hi - lo > 1) bar = xcd_barrier_post((unsigned*)(ctl + CW_BAR) + args.li * XCD_BAR_WORDS, MISC + 8);
#ifndef MK_PHASES
#define MK_PHASES 0xfff
#endif
#define IN(k) ((((MK_PHASES) >> (k)) & 1) && lo <= (k) && (k) < hi)
#define SEAM(k) do { if (IN(k) && IN((k) + 1)) xcd_barrier(bar); } while (0)

    if (IN(0)) { p0_prologue(F, args); __syncthreads(); } SEAM(0);
    if (IN(1)) { p1_norm(F, args); } SEAM(1);
    if (IN(2)) {
        pg8::Gemm g{(const bf16_t*)(F.ws + WS_A1), (const bf16_t*)(F.ws + WS_WIN), DM}; pg8::OrdInProj S{F.G, (int)blockIdx.x};
        pg8::EpiInProj E{(bf16_t*)(F.ws + WS_Z), (bf16_t*)(F.ws + WS_GB), (bf16_t*)(F.ws + WS_Q), (bf16_t*)(F.ws + WS_KALL), (bf16_t*)(F.ws + WS_VALL), (bf16_t*)(F.ws + WS_S6), (bf16_t*)(F.ws + WS_S7),
                         (const LAS float*)(F.lds + ROPE_OFF)};
        pg8::gemm_phase<pg8::EpiInProj, pg8::OrdInProj, true, true>(F.lds, g, S, E);
        if (F.G == 256 && blockIdx.x >= 64) {
            LAS float* scr = (LAS float*)(F.lds + F.wave * FP8_SCR_STRIDE); const int w0 = ((int)blockIdx.x - 64) * NWAVES * WD_EARLY_PER_WAVE + F.wave;
            moe_convert_items(F, args, N_WGU_ITEMS + w0, NWAVES, N_WGU_ITEMS + w0 + NWAVES * WD_EARLY_PER_WAVE, 0, scr);
        }
    } SEAM(2);
    if (IN(3)) { if (!(F.vcu & 1)) { p3_conv(F, args); p3_weight_share(F, args); __syncthreads(); } p3_attn<-1>(F, args, (char*)lds); if (F.vcu & 1) { __syncthreads(); p3_conv(F, args); p3_weight_share(F, args); } __syncthreads(); } SEAM(3);
    if (IN(4)) {
        constexpr size_t TB = (size_t)256 * DM * 2;
        static_assert(WS_A1 % TB == 0 && WS_OATT % TB == 0 && WS_WC % TB == 0 && WS_WO % TB == 0, "virtual tile indices need tile-aligned buffers");
        pg8::OrdMerge S; S.base.init(MX / 256, DM / 256, F.G, (int)blockIdx.x); S.pmA0 = (int)(WS_A1 / TB); S.pmA1 = (int)(WS_OATT / TB); S.pbB0 = (int)(WS_WC / TB); S.pbB1 = (int)(WS_WO / TB);
        pg8::Gemm g{(const bf16_t*)F.ws, (const bf16_t*)F.ws, DM};
        pg8::EpiMerge E{(const bf16_t*)(F.ws + WS_S6), (const bf16_t*)(F.ws + WS_S7), (bf16_t*)(F.ws + WS_MERGED)};
        pg8::gemm_phase<pg8::EpiMerge, pg8::OrdMerge, true, true>(F.lds, g, S, E);
    } SEAM(4);
    if (IN(5)) {
        pg8::OrdGrid S; S.init(MX / 256, DM / 256, F.G, (int)blockIdx.x);
        pg8::Gemm g{(const bf16_t*)(F.ws + WS_MERGED), (const bf16_t*)(F.ws + WS_WOUT), DM}; pg8::EpiOut E{(const float*)(F.ws + WS_MODS), (bf16_t*)(F.ws + WS_MIX)};
        pg8::gemm_phase<pg8::EpiOut, pg8::OrdGrid, false, true>(F.lds, g, S, E);
    } SEAM(5);
    if (IN(6)) { p6_norm_router(F, args); } SEAM(6);
    if (IN(7)) { p7_topk_weights(F, args); __syncthreads(); } SEAM(7);
    if (IN(8)) {
        LAS unsigned* gtab = (LAS unsigned*)(F.lds + GTAB_OFF); const int* gidx = (const int*)(F.ws + WS_GIDX);
        for (int i0 = 0; (long)i0 * F.G < 2048; i0 += 8) {
            pg8::OrdMoe<16> S{F.G, (int)blockIdx.x, i0, 8};
            for (int i = 0; i < 8; ++i) { pg8::Unit u; if (!S.next(i, u)) break; if (F.tid < 256) gtab[i * 256 + F.tid] = (unsigned)gidx[u.pm * 256 + F.tid] * (unsigned)DM; }
            __syncthreads();
            pg8::Gemm g{(const bf16_t*)(F.ws + WS_HX2), (const bf16_t*)(F.ws + WS_WGU), DM / 2}; pg8::EpiSwiGLU E{(unsigned char*)(F.ws + WS_H)};
            pg8::gemm_phase<pg8::EpiSwiGLU, pg8::OrdMoe<16>, true, true, true, true>(F.lds, g, S, E, (const LAS unsigned*)gtab);
            __syncthreads();
        }
    } SEAM(8);
    if (IN(9)) {
        pg8::Gemm g{(const bf16_t*)(F.ws + WS_H), (const bf16_t*)(F.ws + WS_WD), FH / 2}; pg8::OrdMoe<4> S{F.G, (int)blockIdx.x, 0, 1 << 30}; pg8::EpiDown E{(const float*)(F.ws + WS_GATE), (bf16_t*)(F.ws + WS_YG)};
        pg8::gemm_phase<pg8::EpiDown, pg8::OrdMoe<4>, true, true, false, true>(F.lds, g, S, E);
    } SEAM(9);
    if (IN(10)) { p10_final<false>(F, args); }
    if (IN(11)) { p10_final<true>(F, args); }
#undef IN
#undef SEAM
}

#if MK_ATTN_PROBE >= 0
__global__ void __launch_bounds__(NWAVES * 64, 2) mk_attn_probe(Args args) {
    extern __shared__ __attribute__((aligned(16))) unsigned char lds[];
    Frame F; F.lds = (LAS unsigned char*)lds; F.tid = threadIdx.x; F.lane = F.tid & 63; F.wave = __builtin_amdgcn_readfirstlane(F.tid >> 6);
    F.G = gridDim.x; { const int bx = blockIdx.x; F.vcu = (F.G % 8 == 0) ? (bx % 8) * (F.G / 8) + bx / 8 : bx; } F.ws = args.ws;
    p3_attn<MK_ATTN_PROBE>(F, args, (char*)lds);
}
#endif
extern "C" void kernel_launch(void* const* d_in, const int* in_sizes, int n_in, void* d_out, int out_size, void* d_ws, size_t ws_size, hipStream_t stream) {
    static int grid = 0;
    if (grid == 0) {
        if (n_in != 23 || in_sizes[0] != MX * DM || out_size != MX * DM || ws_size < WS_END) {
            fprintf(stderr, "kernel_launch: unexpected shapes: n_in %d in0 %d out %d ws %zu (need %zu)\n", n_in, n_in > 0 ? in_sizes[0] : -1, out_size, ws_size, (size_t)WS_END); grid = -1; return; }
        int dev = 0, cus = 0;
        if (hipGetDevice(&dev) != hipSuccess || hipDeviceGetAttribute(&cus, hipDeviceAttributeMultiprocessorCount, dev) != hipSuccess) { grid = -1; return; }
        if (hipFuncSetAttribute((const void*)mk_fwd, hipFuncAttributeMaxDynamicSharedMemorySize, LDS_BYTES) != hipSuccess) { fprintf(stderr, "kernel_launch: hipFuncSetAttribute failed\n"); grid = -1; return; }
        int per_cu = 0;
        if (hipOccupancyMaxActiveBlocksPerMultiprocessor(&per_cu, (const void*)mk_fwd, NWAVES * 64, LDS_BYTES) != hipSuccess || per_cu < 1) fprintf(stderr, "kernel_launch: occupancy query reports %d\n", per_cu);
        (void)hipGetLastError();
        grid = cus;
    }
    if (grid < 0) return;
    if (hipMemsetAsync((char*)d_ws + WS_CTL, 0, CTL_ZERO_BYTES, stream) != hipSuccess) return;
    Args a{};
    for (int i = 0; i < 23; ++i) a.in[i] = (const float*)d_in[i];
    a.out = (float*)d_out; a.ws = (unsigned char*)d_ws;
#if MK_ATTN_PROBE >= 0
    (void)hipFuncSetAttribute((const void*)mk_attn_probe, hipFuncAttributeMaxDynamicSharedMemorySize, LDS_BYTES);
    a.ph_lo = 0; a.ph_hi = 4; a.li = 0; hipLaunchKernelGGL(mk_fwd, dim3(grid), dim3(NWAVES * 64), LDS_BYTES, stream, a);
    hipLaunchKernelGGL(mk_attn_probe, dim3(grid), dim3(NWAVES * 64), LDS_BYTES, stream, a);
    a.ph_lo = 4; a.ph_hi = N_PHASES; a.li = 1; hipLaunchKernelGGL(mk_fwd, dim3(grid), dim3(NWAVES * 64), LDS_BYTES, stream, a);
    return;
#endif
#ifdef MK_P10_PROBE
    a.ph_lo = 0; a.ph_hi = 10; a.li = 0; hipLaunchKernelGGL(mk_fwd, dim3(grid), dim3(NWAVES * 64), LDS_BYTES, stream, a);
    a.ph_lo = 11; a.ph_hi = 12; a.li = 1; hipLaunchKernelGGL(mk_fwd, dim3(grid), dim3(NWAVES * 64), LDS_BYTES, stream, a);
    a.ph_lo = 10; a.ph_hi = 11; a.li = 1; hipLaunchKernelGGL(mk_fwd, dim3(grid), dim3(NWAVES * 64), LDS_BYTES, stream, a);
    return;
#endif
    if (MK_PROBE_LO >= 0) {
        a.ph_lo = 0; a.ph_hi = MK_PROBE_HI; a.li = 0; hipLaunchKernelGGL(mk_fwd, dim3(grid), dim3(NWAVES * 64), LDS_BYTES, stream, a);
        a.ph_lo = MK_PROBE_LO; a.ph_hi = N_PHASES; a.li = 1; hipLaunchKernelGGL(mk_fwd, dim3(grid), dim3(NWAVES * 64), LDS_BYTES, stream, a);
        return;
    }
    for (int li = 0; li < N_LAUNCHES; ++li) {
        a.ph_lo = (N_LAUNCHES == 1) ? 0 : li; a.ph_hi = (N_LAUNCHES == 1) ? N_PHASES : li + 1; a.li = (N_LAUNCHES == 1) ? 0 : 0;
        hipLaunchKernelGGL(mk_fwd, dim3(grid), dim3(NWAVES * 64), LDS_BYTES, stream, a);
    }
}
```

```cpp
#include <hip/hip_runtime.h>
#include <cstdio>
#include <cstdint>

#ifndef MK_N_LAUNCHES
#define MK_N_LAUNCHES 1
#endif
#ifndef MK_PROBE_LO
#define MK_PROBE_LO -1
#define MK_PROBE_HI -1
#endif
constexpr int N_PHASES = 11;
constexpr int N_LAUNCHES = MK_N_LAUNCHES;

constexpr int DM = 1024, NB = 8, SEQ = 2048, CTXL = 256;
constexpr int MX = NB * SEQ;
constexpr int MC = NB * CTXL;
constexpr int MA = MX + MC;
constexpr int SKV = CTXL + SEQ;
constexpr int NH = 8;
constexpr int NE = 16, FH = 2048, CAP = 256;
constexpr int MS = NE * NB * CAP;
constexpr int NMOD = 6 * DM;
constexpr float EPS = 1e-6f;
constexpr float LAM_INIT = 0.2f;

constexpr size_t MiB = 1u << 20;
constexpr size_t WS_CTL = 0, CTL_ZERO_BYTES = 64 * 1024;
constexpr size_t WS_MODS = 1 * MiB;
constexpr size_t WS_AFF = 2 * MiB;
constexpr size_t WS_SLOT = 3 * MiB;
constexpr size_t WS_GATE = 4 * MiB;
constexpr size_t WS_GIDX = 5 * MiB;
constexpr size_t WS_WIN = 8 * MiB;
constexpr size_t WS_WC = 24 * MiB, WS_WO = 26 * MiB, WS_WOUT = 28 * MiB;
constexpr size_t WS_Z = 32 * MiB, WS_GB = 64 * MiB, WS_Q = 96 * MiB, WS_KALL = 128 * MiB, WS_VALL = 164 * MiB, WS_S6 = 200 * MiB, WS_S7 = 232 * MiB;
constexpr size_t WS_H = 32 * MiB;
constexpr size_t WS_WGU = 428 * MiB;
constexpr size_t WS_A1 = 264 * MiB;
constexpr size_t WS_HX2 = 288 * MiB;
constexpr size_t WS_YG = 288 * MiB;
constexpr size_t WS_OATT = 300 * MiB;
constexpr size_t WS_MERGED = 332 * MiB;
constexpr size_t WS_O1 = 364 * MiB;
constexpr size_t WS_MIX = 364 * MiB;
constexpr size_t WS_WD = 396 * MiB;
constexpr size_t WS_END = 492 * MiB;

constexpr int RING_BYTES = 131072;
constexpr int ROPE_OFF = RING_BYTES;
constexpr int GTAB_OFF = ROPE_OFF + 8192;
constexpr int LDSCTL_OFF = GTAB_OFF + 8192, MISC_OFF = LDSCTL_OFF + 320;
constexpr int LDS_BYTES = 155648;

#define GAS __attribute__((address_space(1)))
#define LAS __attribute__((address_space(3)))
typedef unsigned short bf16_t;
typedef unsigned v4u __attribute__((ext_vector_type(4)));
typedef unsigned v2u __attribute__((ext_vector_type(2)));
typedef float f32x4 __attribute__((ext_vector_type(4)));
typedef float f32x2 __attribute__((ext_vector_type(2)));
typedef short bf16x8 __attribute__((ext_vector_type(8)));
typedef GAS unsigned gu32;
#define RLX_AGENT __ATOMIC_RELAXED, __HIP_MEMORY_SCOPE_AGENT
#define LDS_WAIT() asm volatile("s_waitcnt lgkmcnt(0)" ::: "memory")
#define VM_WAIT() asm volatile("s_waitcnt vmcnt(0)" ::: "memory")

__device__ __forceinline__ unsigned f2bf(float f) { unsigned u = __builtin_bit_cast(unsigned, f); return (u + 0x7fffu + ((u >> 16) & 1u)) >> 16; }
__device__ __forceinline__ unsigned pk2(float lo, float hi) { return f2bf(lo) | (f2bf(hi) << 16); }
__device__ __forceinline__ float bf_lo(unsigned w) { return __builtin_bit_cast(float, w << 16); }
__device__ __forceinline__ float bf_hi(unsigned w) { return __builtin_bit_cast(float, w & 0xffff0000u); }
__device__ __forceinline__ unsigned cvt_pk_bf16(float lo, float hi) { unsigned r; asm volatile("v_cvt_pk_bf16_f32 %0, %1, %2" : "=v"(r) : "v"(lo), "v"(hi)); return r; }
__device__ __forceinline__ float wave_sum(float v) {
#pragma unroll
    for (int o = 1; o < 64; o <<= 1) v += __shfl_xor(v, o);
    return v;
}
__device__ __forceinline__ float swap32(float v, bool lo_half) {
    auto r = __builtin_amdgcn_permlane32_swap(__builtin_bit_cast(unsigned, v), __builtin_bit_cast(unsigned, v), false, false);
    return __builtin_bit_cast(float, lo_half ? r[1] : r[0]);
}
__device__ __forceinline__ unsigned pk_fp8x4(float a, float b, float c, float d) {
    a = __builtin_amdgcn_fmed3f(a, -448.f, 448.f); b = __builtin_amdgcn_fmed3f(b, -448.f, 448.f); c = __builtin_amdgcn_fmed3f(c, -448.f, 448.f); d = __builtin_amdgcn_fmed3f(d, -448.f, 448.f);
    int w = 0; w = __builtin_amdgcn_cvt_pk_fp8_f32(a, b, w, false); w = __builtin_amdgcn_cvt_pk_fp8_f32(c, d, w, true); return (unsigned)w; }
__device__ __forceinline__ float sigmoidf_(float x) { return __builtin_amdgcn_rcpf(1.f + __builtin_amdgcn_exp2f(-1.4426950408889634f * x)); }

namespace pg8 {
#define PG8_LAS __attribute__((address_space(3)))
typedef float f32x4 __attribute__((ext_vector_type(4)));
typedef unsigned u32x4 __attribute__((ext_vector_type(4)));
typedef int v4i_ __attribute__((ext_vector_type(4)));
typedef int v8i_ __attribute__((ext_vector_type(8)));
constexpr int BM = 256, BK = 64, HALF = 128, HTB = HALF * BK * 2, STAGE_BYTES = 8 * HTB, NXCD = 8, WGM = 8;

__host__ __device__ __forceinline__ int lds_byte(int r, int c) { const int st = (r >> 4) * 2 + (c >> 5), rr = r & 15, cc = c & 31, ob = rr * 64 + cc * 2; return st * 1024 + (ob ^ (((ob >> 9) & 1) << 5)); }
__host__ __device__ __forceinline__ void stage_rc(int b, int& R, int& C) { const int st = b / 1024, sb = b % 1024, swz = sb ^ (((sb >> 9) & 1) << 5); R = (st >> 1) * 16 + swz / 64; C = (st & 1) * 32 + (swz % 64) / 2; }
__host__ __device__ __forceinline__ int perm32(int rho) { const int n = rho >> 4, i = rho & 15; return 8 * (i >> 2) + 4 * n + (i & 3); }

struct Unit { int pm, pb, pn; };
struct Gemm { const bf16_t* A; const bf16_t* Bt; int K; };

struct OrdGrid {
    int nM, nN, nwg, G, c;
    __device__ __forceinline__ void init(int nM_, int nN_, int G_, int c_) { nM = nM_; nN = nN_; nwg = nM * nN; G = G_; c = c_; }
    __device__ __forceinline__ bool next(int i, Unit& u) const {
        const long L = (long)i * G + c; if (L >= nwg) return false;
        int wgid = (int)L; { const int q = nwg / NXCD, xcd = wgid % NXCD, off = wgid / NXCD; wgid = xcd * q + off; }
        const int nig = WGM * nN, gid = wgid / nig, fm = gid * WGM;
        u.pm = fm + ((wgid % nig) % WGM); u.pn = (wgid % nig) / WGM; u.pb = u.pn; return true;
    }
};
struct OrdMerge {
    OrdGrid base; int pmA0, pmA1, pbB0, pbB1;
    __device__ __forceinline__ bool next(int i, Unit& u) const {
        Unit t; if (!base.next(i >> 1, t)) return false;
        const int ty = i & 1; u.pm = (ty ? pmA1 : pmA0) + t.pm; u.pb = (ty ? pbB1 : pbB0) + t.pn; u.pn = ty * 4 + t.pn + 8 * t.pm; return true;
    }
};
struct OrdInProj {
    int G, c;
    __device__ __forceinline__ bool next(int i, Unit& u) const {
        const long L = (long)i * G + c; if (L >= 2048 + 64) return false;
        if (L < 2048) { const int wgid = (int)(L % 8) * 256 + (int)(L / 8); const int w = wgid % 256; u.pm = (wgid / 256) * 8 + (w % 8); u.pn = w / 8; }
        else { const int l2 = (int)L - 2048; u.pm = 64 + (l2 & 7); u.pn = 16 + (l2 >> 3); }
        u.pb = u.pn; return true;
    }
};
template <int NT> struct OrdMoe {
    int G, c, i0, imax;
    __device__ __forceinline__ bool next(int i, Unit& u) const {
        constexpr int nwg = 128 * NT;
        if (i >= imax) return false;
        const long L = (long)(i0 + i) * G + c; if (L >= nwg) return false;
        const int wgid = (int)(L % 8) * (nwg / 8) + (int)(L / 8);
        const int e = wgid / (8 * NT), w = wgid % (8 * NT);
        u.pm = e * 8 + (w % 8); u.pn = w / 8; u.pb = e * NT + u.pn; return true;
    }
};

template <class Epi, class Sched, bool ALIGN_EPI = false, bool SP2 = false, bool GATHER = false, bool FP8 = false>
__device__ __forceinline__ void gemm_phase(PG8_LAS unsigned char* lds, const Gemm g, const Sched& S, const Epi& E, const PG8_LAS unsigned* gtab = nullptr) {
    const int tid = threadIdx.x, wid = __builtin_amdgcn_readfirstlane(tid >> 6), lane = tid & 63, wr = wid >> 2, wc = wid & 3, fr = lane & 15, fq = lane >> 4;
    const int K = g.K, nt = K / BK;
    unsigned voffA[2], voffB[2];
#pragma unroll
    for (int i = 0; i < 2; ++i) { int R, C; stage_rc(tid * 16 + i * 8192, R, C); const int Rb = ((R & ~31) + perm32(R & 31));
        voffA[i] = (unsigned)(R * K + C) * 2u; voffB[i] = (unsigned)(Rb * K + C) * 2u; }
    const size_t kstep = (size_t)(BK * 2);
    const size_t hstep = (size_t)HALF * K * 2;
    const size_t tstep = 2 * hstep;
    const unsigned ldsw = (unsigned)wid * 1024u;
    int gR[2], gC2[2];
#pragma unroll
    for (int i = 0; i < 2; ++i) { int R, C; stage_rc(tid * 16 + i * 8192, R, C); gR[i] = R; gC2[i] = C * 2; }
    unsigned cO0[2], cO1[2], nO0[2], nO1[2];
#define PG8_GOFF(O0, O1, ui_) do { _Pragma("unroll") for (int _i = 0; _i < 2; ++_i) { O0[_i] = gtab[((ui_) & 7) * 256 + gR[_i]] + gC2[_i]; O1[_i] = gtab[((ui_) & 7) * 256 + 128 + gR[_i]] + gC2[_i]; } } while (0)
    const int aoff = lds_byte(wr * 64 + fr, fq * 8), boff = lds_byte(wc * 32 + fr, fq * 8);
#define PG8_SA(b, h) (((b) * 2 + (h)) * HTB)
#define PG8_SB(b, h) ((4 + (b) * 2 + (h)) * HTB)
#define PG8_STAGE(bufoff, gbase, voff) do { _Pragma("unroll") for (int _i = 0; _i < 2; ++_i) \
        __builtin_amdgcn_global_load_lds((const unsigned*)((const char*)(gbase) + (voff)[_i]), (PG8_LAS unsigned*)(lds + (bufoff) + ldsw + _i * 8192), 16, 0, 0); } while (0)
#define PG8_LD8(p) __builtin_shufflevector(*(const PG8_LAS v4i_*)(p), *(const PG8_LAS v4i_*)((p) + 1024), 0, 1, 2, 3, 4, 5, 6, 7)
#define PG8_LDA(dst, b, h) do { if constexpr (FP8) { _Pragma("unroll") for (int m = 0; m < 4; ++m) dst##8[m] = PG8_LD8(lds + PG8_SA(b, h) + aoff + m * 2048); } \
        else { _Pragma("unroll") for (int m = 0; m < 4; ++m) _Pragma("unroll") for (int k = 0; k < 2; ++k) dst[m][k] = *(const PG8_LAS bf16x8*)(lds + PG8_SA(b, h) + aoff + m * 2048 + k * 1024); } } while (0)
#define PG8_LDB(dst, b, h) do { if constexpr (FP8) { _Pragma("unroll") for (int n = 0; n < 2; ++n) dst##8[n] = PG8_LD8(lds + PG8_SB(b, h) + boff + n * 2048); } \
        else { _Pragma("unroll") for (int n = 0; n < 2; ++n) _Pragma("unroll") for (int k = 0; k < 2; ++k) dst[n][k] = *(const PG8_LAS bf16x8*)(lds + PG8_SB(b, h) + boff + n * 2048 + k * 1024); } } while (0)
#define PG8_MMA(ai, bj, At, Bt) do { __builtin_amdgcn_s_setprio(1); _Pragma("unroll") for (int m = 0; m < 4; ++m) _Pragma("unroll") for (int n = 0; n < 2; ++n) { \
        if constexpr (FP8) asm("v_mfma_scale_f32_16x16x128_f8f6f4 %0, %1, %2, %0, %3, %4 op_sel_hi:[0,0,0]" : "+v"(acc[ai][bj][m][n]) : "v"(Bt##8[n]), "v"(At##8[m]), "v"(scw8), "v"(sca8)); \
        else { _Pragma("unroll") for (int k = 0; k < 2; ++k) acc[ai][bj][m][n] = __builtin_amdgcn_mfma_f32_16x16x32_bf16(Bt[n][k], At[m][k], acc[ai][bj][m][n], 0, 0, 0); } } __builtin_amdgcn_s_setprio(0); } while (0)
#define PG8_WAIT_V(n) asm volatile("s_waitcnt vmcnt(" #n ")" ::: "memory")
#define PG8_WAIT_L(n) asm volatile("s_waitcnt lgkmcnt(" #n ")" ::: "memory")
#define PG8_BAR __builtin_amdgcn_s_barrier()
#define PG8_SCHED __builtin_amdgcn_sched_barrier(0)
    Unit cur, nxt; int ui = 0;
    if (!S.next(0, cur)) return;
    f32x4 acc[2][2][4][2];
#pragma unroll
    for (int a = 0; a < 2; ++a)
#pragma unroll
        for (int b = 0; b < 2; ++b)
#pragma unroll
            for (int m = 0; m < 4; ++m)
#pragma unroll
                for (int n = 0; n < 2; ++n) acc[a][b][m][n] = (f32x4){0.f, 0.f, 0.f, 0.f};
    int scw8 = 0x7b7b7b7b, sca8 = 0x7f7f7f7f; asm volatile("" : "+v"(scw8), "+v"(sca8));
    bf16x8 At[4][2], B0[2][2], B1[2][2]; v8i_ At8[4], B08[2], B18[2];
    const char* cA = GATHER ? (const char*)g.A : (const char*)g.A + (size_t)cur.pm * tstep; const char* cB = (const char*)g.Bt + (size_t)cur.pb * tstep;
    if constexpr (GATHER) { PG8_GOFF(cO0, cO1, 0); }
    if constexpr (SP2 && GATHER) {
        PG8_STAGE(PG8_SB(0, 0), cB, voffB); PG8_STAGE(PG8_SB(0, 1), cB + hstep, voffB); PG8_STAGE(PG8_SA(0, 0), cA, cO0); PG8_STAGE(PG8_SA(0, 1), cA, cO1);
        if (wr == 1) PG8_BAR;
        PG8_WAIT_V(2); PG8_BAR;
        PG8_STAGE(PG8_SB(1, 0), cB + kstep, voffB); PG8_STAGE(PG8_SA(1, 0), cA + kstep, cO0); PG8_STAGE(PG8_SB(1, 1), cB + hstep + kstep, voffB);
        PG8_WAIT_V(6); PG8_BAR;
    } else if constexpr (SP2) {
        PG8_STAGE(PG8_SB(0, 0), cB, voffB); PG8_STAGE(PG8_SB(0, 1), cB + hstep, voffB); PG8_STAGE(PG8_SA(0, 0), cA, voffA); PG8_STAGE(PG8_SA(0, 1), cA + hstep, voffA);
        if (wr == 1) PG8_BAR;
        PG8_WAIT_V(2); PG8_BAR;
        PG8_STAGE(PG8_SB(1, 0), cB + kstep, voffB); PG8_STAGE(PG8_SA(1, 0), cA + kstep, voffA); PG8_STAGE(PG8_SB(1, 1), cB + hstep + kstep, voffB);
        PG8_WAIT_V(6); PG8_BAR;
    } else {
        PG8_STAGE(PG8_SB(0, 0), cB, voffB); PG8_STAGE(PG8_SA(0, 0), cA, voffA); PG8_STAGE(PG8_SB(0, 1), cB + hstep, voffB); PG8_STAGE(PG8_SA(0, 1), cA + hstep, voffA);
        if (wr == 1) PG8_BAR;
        PG8_WAIT_V(4); PG8_BAR;
        PG8_STAGE(PG8_SB(1, 0), cB + kstep, voffB); PG8_STAGE(PG8_SA(1, 0), cA + kstep, voffA); PG8_STAGE(PG8_SB(1, 1), cB + hstep + kstep, voffB);
        PG8_WAIT_V(6); PG8_BAR;
    }
    for (;;) {
        const bool has_next = S.next(ui + 1, nxt);
        const char* nA = GATHER ? cA : (has_next ? (const char*)g.A + (size_t)nxt.pm * tstep : cA); const char* nB = has_next ? (const char*)g.Bt + (size_t)nxt.pb * tstep : cB;
        if constexpr (GATHER) { if (has_next) { PG8_GOFF(nO0, nO1, ui + 1); } else {
#pragma unroll
            for (int _i = 0; _i < 2; ++_i) { nO0[_i] = cO0[_i]; nO1[_i] = cO1[_i]; } } }
        for (int t = 0; t < nt; t += 2) {
            const bool last = (t == nt - 2);
            const char* a1 = cA + (size_t)(t + 1) * kstep;
            const char* a2 = last ? nA : cA + (size_t)(t + 2) * kstep; const char* b2 = last ? nB : cB + (size_t)(t + 2) * kstep;
            const char* a3 = a2 + kstep; const char* b3 = b2 + kstep;
            if constexpr (SP2 && GATHER) {
            unsigned s0[2], s1[2];
#pragma unroll
            for (int _i = 0; _i < 2; ++_i) { s0[_i] = last ? nO0[_i] : cO0[_i]; s1[_i] = last ? nO1[_i] : cO1[_i]; }
            const char* g2 = last ? cA : cA + (size_t)(t + 2) * kstep; const char* g3 = g2 + kstep;
            PG8_LDB(B0, 0, 0); PG8_LDB(B1, 0, 1); PG8_SCHED; PG8_LDA(At, 0, 0); PG8_STAGE(PG8_SA(1, 1), a1, cO1);
            PG8_WAIT_V(8); PG8_WAIT_L(0); PG8_BAR; PG8_MMA(0, 0, At, B0); PG8_MMA(0, 1, At, B1); PG8_BAR; PG8_SCHED;
            PG8_LDA(At, 0, 1); PG8_STAGE(PG8_SB(0, 0), b2, voffB); PG8_STAGE(PG8_SB(0, 1), b2 + hstep, voffB); PG8_STAGE(PG8_SA(0, 0), g2, s0);
            PG8_WAIT_V(8); PG8_WAIT_L(0); PG8_BAR; PG8_MMA(1, 0, At, B0); PG8_MMA(1, 1, At, B1); PG8_BAR; PG8_SCHED;
            PG8_LDB(B0, 1, 0); PG8_LDB(B1, 1, 1); PG8_SCHED; PG8_LDA(At, 1, 0); PG8_STAGE(PG8_SA(0, 1), g2, s1);
            PG8_WAIT_V(8); PG8_WAIT_L(0); PG8_BAR; PG8_MMA(0, 0, At, B0); PG8_MMA(0, 1, At, B1); PG8_BAR; PG8_SCHED;
            PG8_LDA(At, 1, 1); PG8_STAGE(PG8_SB(1, 0), b3, voffB); PG8_STAGE(PG8_SB(1, 1), b3 + hstep, voffB); PG8_STAGE(PG8_SA(1, 0), g3, s0);
            PG8_WAIT_V(8); PG8_WAIT_L(0); PG8_BAR; PG8_MMA(1, 0, At, B0); PG8_MMA(1, 1, At, B1); PG8_BAR; PG8_SCHED;
            } else if constexpr (SP2) {
            PG8_LDB(B0, 0, 0); PG8_LDB(B1, 0, 1); PG8_SCHED; PG8_LDA(At, 0, 0); PG8_STAGE(PG8_SA(1, 1), a1 + hstep, voffA);
            PG8_WAIT_V(8); PG8_WAIT_L(0); PG8_BAR; PG8_MMA(0, 0, At, B0); PG8_MMA(0, 1, At, B1); PG8_BAR; PG8_SCHED;
            PG8_LDA(At, 0, 1); PG8_STAGE(PG8_SB(0, 0), b2, voffB); PG8_STAGE(PG8_SB(0, 1), b2 + hstep, voffB); PG8_STAGE(PG8_SA(0, 0), a2, voffA);
            PG8_WAIT_V(8); PG8_WAIT_L(0); PG8_BAR; PG8_MMA(1, 0, At, B0); PG8_MMA(1, 1, At, B1); PG8_BAR; PG8_SCHED;
            PG8_LDB(B0, 1, 0); PG8_LDB(B1, 1, 1); PG8_SCHED; PG8_LDA(At, 1, 0); PG8_STAGE(PG8_SA(0, 1), a2 + hstep, voffA);
            PG8_WAIT_V(8); PG8_WAIT_L(0); PG8_BAR; PG8_MMA(0, 0, At, B0); PG8_MMA(0, 1, At, B1); PG8_BAR; PG8_SCHED;
            PG8_LDA(At, 1, 1); PG8_STAGE(PG8_SB(1, 0), b3, voffB); PG8_STAGE(PG8_SB(1, 1), b3 + hstep, voffB); PG8_STAGE(PG8_SA(1, 0), a3, voffA);
            PG8_WAIT_V(8); PG8_WAIT_L(0); PG8_BAR; PG8_MMA(1, 0, At, B0); PG8_MMA(1, 1, At, B1); PG8_BAR; PG8_SCHED;
            } else {
            PG8_LDB(B0, 0, 0); PG8_SCHED; PG8_LDA(At, 0, 0); PG8_STAGE(PG8_SA(1, 1), a1 + hstep, voffA);
            PG8_WAIT_L(8); PG8_BAR; PG8_WAIT_L(0); PG8_MMA(0, 0, At, B0); PG8_BAR; PG8_SCHED;
            PG8_LDB(B1, 0, 1); PG8_STAGE(PG8_SB(0, 0), b2, voffB);
            PG8_BAR; PG8_WAIT_L(0); PG8_MMA(0, 1, At, B1); PG8_BAR;
            PG8_LDA(At, 0, 1); PG8_STAGE(PG8_SA(0, 0), a2, voffA);
            PG8_BAR; PG8_WAIT_L(0); PG8_MMA(1, 0, At, B0); PG8_BAR; PG8_SCHED;
            PG8_STAGE(PG8_SB(0, 1), b2 + hstep, voffB);
            PG8_WAIT_V(6); PG8_BAR; PG8_MMA(1, 1, At, B1); PG8_BAR;
            PG8_LDB(B0, 1, 0); PG8_SCHED; PG8_LDA(At, 1, 0); PG8_STAGE(PG8_SA(0, 1), a2 + hstep, voffA);
            PG8_WAIT_L(8); PG8_BAR; PG8_WAIT_L(0); PG8_MMA(0, 0, At, B0); PG8_BAR; PG8_SCHED;
            PG8_LDB(B1, 1, 1); PG8_STAGE(PG8_SB(1, 0), b3, voffB);
            PG8_BAR; PG8_WAIT_L(0); PG8_MMA(0, 1, At, B1); PG8_BAR;
            PG8_LDA(At, 1, 1); PG8_STAGE(PG8_SA(1, 0), a3, voffA);
            PG8_BAR; PG8_WAIT_L(0); PG8_MMA(1, 0, At, B0); PG8_BAR; PG8_SCHED;
            PG8_STAGE(PG8_SB(1, 1), b3 + hstep, voffB);
            PG8_WAIT_V(6); PG8_BAR; PG8_MMA(1, 1, At, B1); PG8_BAR;
            }
        }
        if constexpr (ALIGN_EPI) { if (wr == 0) PG8_BAR; }
        if constexpr (FP8) asm volatile("s_nop 15\n\ts_nop 15" ::: "memory");
        E(acc, cur, wr, wc, fr, fq);
        if (!has_next) break;
        if (!Epi::keep_acc(cur)) {
#pragma unroll
        for (int a = 0; a < 2; ++a)
#pragma unroll
            for (int b = 0; b < 2; ++b)
#pragma unroll
                for (int m = 0; m < 4; ++m)
#pragma unroll
                    for (int n = 0; n < 2; ++n) acc[a][b][m][n] = (f32x4){0.f, 0.f, 0.f, 0.f}; }
        if constexpr (FP8) asm volatile("s_nop 4" ::: "memory");
        cur = nxt; cA = nA; cB = nB; ++ui;
        if constexpr (GATHER) {
#pragma unroll
            for (int _i = 0; _i < 2; ++_i) { cO0[_i] = nO0[_i]; cO1[_i] = nO1[_i]; } }
        if constexpr (ALIGN_EPI) { if (wr == 1) PG8_BAR; }
    }
    PG8_WAIT_V(0);
    if constexpr (!ALIGN_EPI) { if (wr == 0) PG8_BAR; }
    PG8_BAR;
#undef PG8_GOFF
#undef PG8_SA
#undef PG8_SB
#undef PG8_STAGE
#undef PG8_LDA
#undef PG8_LDB
#undef PG8_MMA
#undef PG8_LD8
#undef PG8_WAIT_V
#undef PG8_WAIT_L
#undef PG8_BAR
#undef PG8_SCHED
}

typedef f32x4 Acc[2][2][4][2];
__device__ __forceinline__ v4u pack8(f32x4 v0, f32x4 v1) { v4u w; w.x = cvt_pk_bf16(v0[0], v0[1]); w.y = cvt_pk_bf16(v0[2], v0[3]); w.z = cvt_pk_bf16(v1[0], v1[1]); w.w = cvt_pk_bf16(v1[2], v1[3]); return w; }
__device__ __forceinline__ void unpack8(v4u w, f32x4& v0, f32x4& v1) { v0 = (f32x4){bf_lo(w.x), bf_hi(w.x), bf_lo(w.y), bf_hi(w.y)}; v1 = (f32x4){bf_lo(w.z), bf_hi(w.z), bf_lo(w.w), bf_hi(w.w)}; }

struct EpiInProj {
    bf16_t *Z, *GB, *Q, *KALL, *VALL, *S6, *S7; const LAS float* rope;
    static __device__ __forceinline__ bool keep_acc(const Unit&) { return false; }
    __device__ __forceinline__ void operator()(Acc& acc, const Unit& u, int wr, int wc, int fr, int fq) const {
        const int pn = u.pn, row0 = u.pm * BM + wr * 64 + fr, cw = wc * 32 + 8 * fq;
        if (pn < 8) {
#pragma unroll
            for (int ai = 0; ai < 2; ++ai)
#pragma unroll
                for (int m = 0; m < 4; ++m) { const int row = row0 + ai * HALF + m * 16;
                    *(v4u*)(Z + (size_t)row * DM + pn * 128 + cw) = pack8(acc[ai][0][m][0] * acc[ai][1][m][0], acc[ai][0][m][1] * acc[ai][1][m][1]); }
        } else if (pn < 12) {
#pragma unroll
            for (int ai = 0; ai < 2; ++ai)
#pragma unroll
                for (int m = 0; m < 4; ++m) { const int row = row0 + ai * HALF + m * 16;
#pragma unroll
                    for (int bj = 0; bj < 2; ++bj) *(v4u*)(GB + (size_t)row * DM + (pn - 8) * 256 + bj * HALF + cw) = pack8(acc[ai][bj][m][0], acc[ai][bj][m][1]); }
        } else if (pn < 20) {
            const bool isK = pn >= 16, ctx = u.pm >= 64; const int colb = (pn - (isK ? 16 : 12)) * 256 + cw;
            const bool lo_half = fq < 2; const float sgn = lo_half ? -1.f : 1.f; const int axis = wc & 1, fsel = (fq & 1) * 8;
#pragma unroll
            for (int ai = 0; ai < 2; ++ai)
#pragma unroll
                for (int m = 0; m < 4; ++m) { const int row = row0 + ai * HALF + m * 16;
                    size_t orow; f32x4 cs[4] = {};
                    if (ctx) { const int rc = row - MX; orow = (size_t)(rc >> 8) * SKV + (rc & 255); }
                    else { const int t = row & (SEQ - 1), pos = axis ? (t & 63) : (t >> 6); orow = isK ? (size_t)(row >> 11) * SKV + CTXL + t : (size_t)row;
                        const LAS f32x4* tb = (const LAS f32x4*)(rope + (pos * 16 + fsel) * 2);
#pragma unroll
                        for (int i = 0; i < 4; ++i) cs[i] = tb[i]; }
                    bf16_t* dst = (isK ? KALL : Q) + orow * DM + colb;
#pragma unroll
                    for (int bj = 0; bj < 2; ++bj)
#pragma unroll
                        for (int n = 0; n < 2; ++n) { f32x4 o;
#pragma unroll
                            for (int j = 0; j < 4; ++j) { const float own = acc[ai][bj][m][n][j];
                                if (ctx) o[j] = own;
                                else { const float par = swap32(own, lo_half); const int f = 4 * n + j; const float c = cs[f >> 1][(f & 1) * 2], s = cs[f >> 1][(f & 1) * 2 + 1]; o[j] = own * c + par * (sgn * s); } }
                            v2u w; w.x = cvt_pk_bf16(o[0], o[1]); w.y = cvt_pk_bf16(o[2], o[3]); *(v2u*)(dst + bj * HALF + 4 * n) = w; }
                    asm volatile("" ::: "memory"); }
        } else if (pn < 24) {
            const bool ctx = u.pm >= 64;
#pragma unroll
            for (int ai = 0; ai < 2; ++ai)
#pragma unroll
                for (int m = 0; m < 4; ++m) { const int row = row0 + ai * HALF + m * 16;
                    size_t orow; if (ctx) { const int rc = row - MX; orow = (size_t)(rc >> 8) * SKV + (rc & 255); } else orow = (size_t)(row >> 11) * SKV + CTXL + (row & (SEQ - 1));
#pragma unroll
                    for (int bj = 0; bj < 2; ++bj) *(v4u*)(VALL + orow * DM + (pn - 20) * 256 + bj * HALF + cw) = pack8(acc[ai][bj][m][0], acc[ai][bj][m][1]); }
        } else {
            bf16_t* dstb = pn < 28 ? S6 : S7; const int colb = (pn - (pn < 28 ? 24 : 28)) * 256 + cw;
#pragma unroll
            for (int ai = 0; ai < 2; ++ai)
#pragma unroll
                for (int m = 0; m < 4; ++m) { const int row = row0 + ai * HALF + m * 16;
#pragma unroll
                    for (int bj = 0; bj < 2; ++bj) { f32x4 a = acc[ai][bj][m][0], b = acc[ai][bj][m][1];
#pragma unroll
                        for (int j = 0; j < 4; ++j) { a[j] = sigmoidf_(a[j]); b[j] = sigmoidf_(b[j]); }
                        *(v4u*)(dstb + (size_t)row * DM + colb + bj * HALF) = pack8(a, b); } }
        }
    }
};
struct EpiT1 {
    const bf16_t* S6; float* T;
    static __device__ __forceinline__ bool keep_acc(const Unit&) { return false; }
    __device__ __forceinline__ void operator()(Acc& acc, const Unit& u, int wr, int wc, int fr, int fq) const {
        const int row0 = u.pm * BM + wr * 64 + fr, col0 = u.pn * BM + wc * 32 + 8 * fq;
#pragma unroll
        for (int ai = 0; ai < 2; ++ai)
#pragma unroll
            for (int m = 0; m < 4; ++m) { const size_t off = (size_t)(row0 + ai * HALF + m * 16) * DM + col0;
#pragma unroll
                for (int bj = 0; bj < 2; ++bj) { f32x4 g0, g1; unpack8(*(const v4u*)(S6 + off + bj * HALF), g0, g1);
                    *(f32x4*)(T + off + bj * HALF) = g0 * acc[ai][bj][m][0]; *(f32x4*)(T + off + bj * HALF + 4) = g1 * acc[ai][bj][m][1]; } }
    }
};
struct EpiT2 {
    const bf16_t* S7; const float* T; bf16_t* MG;
    static __device__ __forceinline__ bool keep_acc(const Unit&) { return false; }
    __device__ __forceinline__ void operator()(Acc& acc, const Unit& u, int wr, int wc, int fr, int fq) const {
        const int row0 = u.pm * BM + wr * 64 + fr, col0 = u.pn * BM + wc * 32 + 8 * fq;
#pragma unroll
        for (int ai = 0; ai < 2; ++ai)
#pragma unroll
            for (int m = 0; m < 4; ++m) { const size_t off = (size_t)(row0 + ai * HALF + m * 16) * DM + col0;
#pragma unroll
                for (int bj = 0; bj < 2; ++bj) { f32x4 g0, g1; unpack8(*(const v4u*)(S7 + off + bj * HALF), g0, g1);
                    const f32x4 t0 = *(const f32x4*)(T + off + bj * HALF), t1 = *(const f32x4*)(T + off + bj * HALF + 4);
                    *(v4u*)(MG + off + bj * HALF) = pack8(t0 + g0 * acc[ai][bj][m][0], t1 + g1 * acc[ai][bj][m][1]); } }
    }
};
struct EpiMerge {
    const bf16_t* S6; const bf16_t* S7; bf16_t* MG;
    static __device__ __forceinline__ bool keep_acc(const Unit& u) { return ((u.pn >> 2) & 1) == 0; }
    __device__ __forceinline__ void operator()(Acc& acc, const Unit& u, int wr, int wc, int fr, int fq) const {
        const int ty = (u.pn >> 2) & 1, pnc = u.pn & 3, pmr = u.pn >> 3;
        const int row0 = pmr * BM + wr * 64 + fr, col0 = pnc * BM + wc * 32 + 8 * fq;
        if (ty == 0) {
#pragma unroll
            for (int ai = 0; ai < 2; ++ai)
#pragma unroll
                for (int m = 0; m < 4; ++m) { const size_t off = (size_t)(row0 + ai * HALF + m * 16) * DM + col0;
#pragma unroll
                    for (int bj = 0; bj < 2; ++bj) { f32x4 g0, g1, h0, h1; unpack8(*(const v4u*)(S6 + off + bj * HALF), g0, g1); unpack8(*(const v4u*)(S7 + off + bj * HALF), h0, h1);
#pragma unroll
                        for (int j = 0; j < 4; ++j) { acc[ai][bj][m][0][j] *= g0[j] * __builtin_amdgcn_rcpf(h0[j]); acc[ai][bj][m][1][j] *= g1[j] * __builtin_amdgcn_rcpf(h1[j]); } } }
        } else {
#pragma unroll
            for (int ai = 0; ai < 2; ++ai)
#pragma unroll
                for (int m = 0; m < 4; ++m) { const size_t off = (size_t)(row0 + ai * HALF + m * 16) * DM + col0;
#pragma unroll
                    for (int bj = 0; bj < 2; ++bj) { f32x4 h0, h1; unpack8(*(const v4u*)(S7 + off + bj * HALF), h0, h1);
                        *(v4u*)(MG + off + bj * HALF) = pack8(h0 * acc[ai][bj][m][0], h1 * acc[ai][bj][m][1]); } }
        }
    }
};
struct EpiOut {
    const float* mods; bf16_t* MIX;
    static __device__ __forceinline__ bool keep_acc(const Unit&) { return false; }
    __device__ __forceinline__ void operator()(Acc& acc, const Unit& u, int wr, int wc, int fr, int fq) const {
        const int row0 = u.pm * BM + wr * 64 + fr, col0 = u.pn * BM + wc * 32 + 8 * fq, b = (u.pm * BM) >> 11;
        f32x4 g[2][2];
#pragma unroll
        for (int bj = 0; bj < 2; ++bj)
#pragma unroll
            for (int n = 0; n < 2; ++n) g[bj][n] = *(const f32x4*)(mods + (size_t)b * NMOD + 2 * DM + col0 + bj * HALF + 4 * n);
#pragma unroll
        for (int ai = 0; ai < 2; ++ai)
#pragma unroll
            for (int m = 0; m < 4; ++m) { const size_t off = (size_t)(row0 + ai * HALF + m * 16) * DM + col0;
#pragma unroll
                for (int bj = 0; bj < 2; ++bj) *(v4u*)(MIX + off + bj * HALF) = pack8(g[bj][0] * acc[ai][bj][m][0], g[bj][1] * acc[ai][bj][m][1]); }
    }
};
struct EpiSwiGLU {
    unsigned char* H;
    static __device__ __forceinline__ bool keep_acc(const Unit&) { return false; }
    __device__ __forceinline__ void operator()(Acc& acc, const Unit& u, int wr, int wc, int fr, int fq) const {
        const int row0 = u.pm * BM + wr * 64 + fr, col0 = u.pn * 128 + wc * 32 + 8 * fq;
#pragma unroll
        for (int ai = 0; ai < 2; ++ai)
#pragma unroll
            for (int m = 0; m < 4; ++m) { f32x4 o[2];
#pragma unroll
                for (int n = 0; n < 2; ++n)
#pragma unroll
                    for (int j = 0; j < 4; ++j) { const float g = acc[ai][0][m][n][j]; o[n][j] = (g * acc[ai][1][m][n][j]) * __builtin_amdgcn_rcpf(1.f + __builtin_amdgcn_exp2f(g)); }
                v2u w; w.x = pk_fp8x4(o[0][0], o[0][1], o[0][2], o[0][3]); w.y = pk_fp8x4(o[1][0], o[1][1], o[1][2], o[1][3]);
                *(v2u*)(H + (size_t)(row0 + ai * HALF + m * 16) * FH + col0) = w; }
    }
};
struct EpiDown {
    const float* gate; bf16_t* YG;
    static __device__ __forceinline__ bool keep_acc(const Unit&) { return false; }
    __device__ __forceinline__ void operator()(Acc& acc, const Unit& u, int wr, int wc, int fr, int fq) const {
        const int row0 = u.pm * BM + wr * 64 + fr, col0 = u.pn * BM + wc * 32 + 8 * fq;
#pragma unroll
        for (int ai = 0; ai < 2; ++ai)
#pragma unroll
            for (int m = 0; m < 4; ++m) { const int row = row0 + ai * HALF + m * 16; const float gt = gate[row];
#pragma unroll
                for (int bj = 0; bj < 2; ++bj) *(v4u*)(YG + (size_t)row * DM + col0 + bj * HALF) = pack8(acc[ai][bj][m][0] * gt, acc[ai][bj][m][1] * gt); }
    }
};
}

namespace att {
using s16x4 = __attribute__((ext_vector_type(4))) short;
using f32x16 = __attribute__((ext_vector_type(16))) float;
using u32x4 = __attribute__((ext_vector_type(4))) unsigned;
constexpr int NW = 8, QBLK = 32, KVBLK = 64, LD = 1024;
constexpr float SCALE = 0.125f;
constexpr float THR = 8.f;
constexpr size_t SHM_V = KVBLK * 128 * 2, SHM_K = KVBLK * 64 * 2, NSLOT = 3, SHM_ATTN = NSLOT * (SHM_V + SHM_K) + NW * 64 * 4;
#define KSWZ(row, chunk) ((row) * 128 + ((((chunk) ^ ((row) >> 1)) & 7) << 4))
#define SBAR() __builtin_amdgcn_sched_barrier(0)
#ifndef MK_ATTN_PROBE
#define MK_ATTN_PROBE -1
#endif
#define AV_NOSM(V) ((V) == 5 || (V) == 6 || (V) == 7 || (V) == 8 || (V) == 9 || (V) == 10)
#define AV_NOSTAGE(V) ((V) == 9 || (V) == 10)
#define AV_NOPV(V) ((V) == 2 || (V) == 6)
#define AV_NOQK(V) ((V) == 4 || (V) == 7)
#define AV_NOSYNC(V) ((V) == 3 || (V) == 8 || (V) == 10)
__device__ __forceinline__ int crow(int r, int hi) { return (r & 3) + 8 * (r >> 2) + 4 * hi; }
__device__ __forceinline__ unsigned cvtpk(float lo, float hi) { unsigned r; asm volatile("v_cvt_pk_bf16_f32 %0, %1, %2" : "=v"(r) : "v"(lo), "v"(hi)); return r; }

__device__ __forceinline__ void partialSM(f32x16& p0, f32x16& p1, float& m_reg, float& mn, float& alpha) {
  constexpr float C = SCALE * 1.4426950408889634f;
  float pmax = p0[0];
#pragma unroll
  for (int r = 1; r < 16; ++r) pmax = fmaxf(pmax, p0[r]);
#pragma unroll
  for (int r = 0; r < 16; ++r) pmax = fmaxf(pmax, p1[r]);
  { auto rr = __builtin_amdgcn_permlane32_swap(__float_as_uint(pmax), __float_as_uint(pmax), false, false);
    pmax = fmaxf(__uint_as_float(rr[0]), __uint_as_float(rr[1])); }
  if (__builtin_expect(__all(pmax - m_reg <= THR / SCALE), 1)) { mn = m_reg; alpha = 1.f; }
  else { mn = fmaxf(m_reg, pmax); alpha = __builtin_amdgcn_exp2f((m_reg - mn) * C); m_reg = mn; }
  float mnC = -mn * C;
#pragma unroll
  for (int r = 0; r < 16; ++r) p0[r] = fmaf(p0[r], C, mnC);
#pragma unroll
  for (int r = 0; r < 16; ++r) p1[r] = fmaf(p1[r], C, mnC);
#pragma unroll
  for (int r = 0; r < 16; ++r) p0[r] = __builtin_amdgcn_exp2f(p0[r]);
#pragma unroll
  for (int r = 0; r < 16; ++r) p1[r] = __builtin_amdgcn_exp2f(p1[r]);
}
template <int VAR> __device__ __forceinline__ void finishSM(f32x16& p0, f32x16& p1, float alpha, float& l_reg, bf16x8& pa0, bf16x8& pa1, bf16x8& pa2, bf16x8& pa3) {
  if constexpr (AV_NOSM(VAR)) { asm volatile("" : "+v"(p0), "+v"(p1)); pa0 = pa1 = pa2 = pa3 = *reinterpret_cast<bf16x8*>(&p0); return; }
  float ps = 0;
#pragma unroll
  for (int r = 0; r < 16; ++r) ps += p0[r];
#pragma unroll
  for (int r = 0; r < 16; ++r) ps += p1[r];
  { auto rr = __builtin_amdgcn_permlane32_swap(__float_as_uint(ps), __float_as_uint(ps), false, false);
    ps = __uint_as_float(rr[0]) + __uint_as_float(rr[1]); }
  l_reg = l_reg * alpha + ps;
#define PK4(P, BASE, OUT) do { unsigned a0 = cvtpk(P[BASE + 0], P[BASE + 1]), a1 = cvtpk(P[BASE + 2], P[BASE + 3]);   \
    unsigned b0 = cvtpk(P[BASE + 4], P[BASE + 5]), b1 = cvtpk(P[BASE + 6], P[BASE + 7]);                              \
    auto r0 = __builtin_amdgcn_permlane32_swap(a0, b0, false, false); auto r1 = __builtin_amdgcn_permlane32_swap(a1, b1, false, false); \
    u32x4 w = {r0[0], r1[0], r0[1], r1[1]}; OUT = *reinterpret_cast<bf16x8*>(&w); } while (0)
  PK4(p0, 0, pa0); PK4(p0, 8, pa1); PK4(p1, 0, pa2); PK4(p1, 8, pa3);
#undef PK4
}
template <int VAR> __device__ __forceinline__ void qkt(f32x16& p0, f32x16& p1, const char* Ks, const bf16x8* qr, int r32, int hi) {
  p0 = f32x16{}; p1 = f32x16{};
  if constexpr (AV_NOQK(VAR)) { asm volatile("" : "+v"(p0), "+v"(p1)); return; }
#pragma unroll
  for (int d0 = 0; d0 < 4; ++d0) { const int ch = d0 * 2 + hi;
    bf16x8 b0 = *reinterpret_cast<const bf16x8*>(Ks + KSWZ(r32, ch));
    bf16x8 b1 = *reinterpret_cast<const bf16x8*>(Ks + KSWZ(32 + r32, ch));
    p0 = __builtin_amdgcn_mfma_f32_32x32x16_bf16(b0, qr[d0], p0, 0, 0, 0);
    p1 = __builtin_amdgcn_mfma_f32_32x32x16_bf16(b1, qr[d0], p1, 0, 0, 0); }
}
__device__ __forceinline__ int v_st(int k, int c) { const int kk = (k & ~0xC) | ((k & 4) << 1) | ((k & 8) >> 1); return ((kk >> 3) * 4 + (c >> 5)) * 512 + ((kk & 7) * 32 + (c & 31)) * 2; }
__device__ __forceinline__ int v_rd_base(int lane) { return ((lane & 3) << 3) | (((lane >> 2) & 3) << 6) | (((lane >> 4) & 1) << 5) | (((lane >> 5) & 1) << 8); }
constexpr int v_rd_off(int d0, int ks, int half) { return d0 * 512 + ks * 4096 + half * 2048; }
template <int OFF> __device__ __forceinline__ s16x4 tr_read(int vb) {
  s16x4 r; asm volatile("ds_read_b64_tr_b16 %0, %1 offset:%2" : "=&v"(r) : "v"(vb), "i"(OFF) : "memory"); return r;
}
struct VFrag { s16x4 l0, h0, l1, h1, l2, h2, l3, h3; };
template <int D0> __device__ __forceinline__ void v_reads(VFrag& f, int vb) {
  f.l0 = tr_read<v_rd_off(D0, 0, 0)>(vb); f.h0 = tr_read<v_rd_off(D0, 0, 1)>(vb); f.l1 = tr_read<v_rd_off(D0, 1, 0)>(vb); f.h1 = tr_read<v_rd_off(D0, 1, 1)>(vb);
  f.l2 = tr_read<v_rd_off(D0, 2, 0)>(vb); f.h2 = tr_read<v_rd_off(D0, 2, 1)>(vb); f.l3 = tr_read<v_rd_off(D0, 3, 0)>(vb); f.h3 = tr_read<v_rd_off(D0, 3, 1)>(vb);
}
template <int VAR> __device__ __forceinline__ void pv_mma(f32x16& od, const VFrag& f, bf16x8 pa0, bf16x8 pa1, bf16x8 pa2, bf16x8 pa3) {
  if constexpr (AV_NOPV(VAR)) { asm volatile("" : "+v"(od)); return; }
#define PK(L, H) (bf16x8){L[0], L[1], L[2], L[3], H[0], H[1], H[2], H[3]}
  od = __builtin_amdgcn_mfma_f32_32x32x16_bf16(pa0, PK(f.l0, f.h0), od, 0, 0, 0);
  od = __builtin_amdgcn_mfma_f32_32x32x16_bf16(pa1, PK(f.l1, f.h1), od, 0, 0, 0);
  od = __builtin_amdgcn_mfma_f32_32x32x16_bf16(pa2, PK(f.l2, f.h2), od, 0, 0, 0);
  od = __builtin_amdgcn_mfma_f32_32x32x16_bf16(pa3, PK(f.l3, f.h3), od, 0, 0, 0);
#undef PK
}
#define LWAIT(n) do { asm volatile("s_waitcnt lgkmcnt(" #n ")" ::: "memory"); SBAR(); } while (0)
template <int VAR> __device__ __forceinline__ void pv_sm(f32x16* o, int vb, bf16x8 pa0, bf16x8 pa1, bf16x8 pa2, bf16x8 pa3, f32x16& p0, f32x16& p1, float& m_reg, float& alpha) {
  constexpr float C = SCALE * 1.4426950408889634f;
  VFrag fa, fb;
  v_reads<0>(fa, vb); v_reads<1>(fb, vb); LWAIT(8);
  pv_mma<VAR>(o[0], fa, pa0, pa1, pa2, pa3);
  if constexpr (AV_NOSM(VAR)) {
    v_reads<2>(fa, vb); LWAIT(8); pv_mma<VAR>(o[1], fb, pa0, pa1, pa2, pa3);
    v_reads<3>(fb, vb); LWAIT(8); pv_mma<VAR>(o[2], fa, pa0, pa1, pa2, pa3);
    LWAIT(0); pv_mma<VAR>(o[3], fb, pa0, pa1, pa2, pa3); alpha = 1.f; asm volatile("" : "+v"(p0), "+v"(p1)); return;
  }
  float pmax = p0[0];
#pragma unroll
  for (int r = 1; r < 16; ++r) pmax = fmaxf(pmax, p0[r]);
#pragma unroll
  for (int r = 0; r < 16; ++r) pmax = fmaxf(pmax, p1[r]);
  { auto rr = __builtin_amdgcn_permlane32_swap(__float_as_uint(pmax), __float_as_uint(pmax), false, false);
    pmax = fmaxf(__uint_as_float(rr[0]), __uint_as_float(rr[1])); }
  asm volatile("" : "+v"(pmax));
  v_reads<2>(fa, vb); LWAIT(8);
  pv_mma<VAR>(o[1], fb, pa0, pa1, pa2, pa3);
  const bool keep = __all(pmax - m_reg <= THR / SCALE);
  const float mn = keep ? m_reg : fmaxf(m_reg, pmax);
  alpha = keep ? 1.f : __builtin_amdgcn_exp2f((m_reg - mn) * C); m_reg = mn;
  const float mnC = -mn * C;
#pragma unroll
  for (int r = 0; r < 16; ++r) p0[r] = fmaf(p0[r], C, mnC);
#pragma unroll
  for (int r = 0; r < 16; ++r) p1[r] = fmaf(p1[r], C, mnC);
  asm volatile("" : "+v"(p0), "+v"(p1));
  v_reads<3>(fb, vb); LWAIT(8);
  pv_mma<VAR>(o[2], fa, pa0, pa1, pa2, pa3);
  if constexpr (VAR != 1) {
#pragma unroll
  for (int r = 0; r < 16; ++r) p0[r] = __builtin_amdgcn_exp2f(p0[r]); }
  asm volatile("" : "+v"(p0));
  LWAIT(0);
  pv_mma<VAR>(o[3], fb, pa0, pa1, pa2, pa3);
  if constexpr (VAR != 1) {
#pragma unroll
  for (int r = 0; r < 16; ++r) p1[r] = __builtin_amdgcn_exp2f(p1[r]); }
  asm volatile("" : "+v"(p1));
}
template <int VAR> __device__ __forceinline__ void pv_d0(f32x16* o, int vb, bf16x8 pa0, bf16x8 pa1, bf16x8 pa2, bf16x8 pa3) {
  VFrag fa, fb;
  v_reads<0>(fa, vb); v_reads<1>(fb, vb); LWAIT(8); pv_mma<VAR>(o[0], fa, pa0, pa1, pa2, pa3);
  v_reads<2>(fa, vb); LWAIT(8); pv_mma<VAR>(o[1], fb, pa0, pa1, pa2, pa3);
  v_reads<3>(fb, vb); LWAIT(8); pv_mma<VAR>(o[2], fa, pa0, pa1, pa2, pa3);
  LWAIT(0); pv_mma<VAR>(o[3], fb, pa0, pa1, pa2, pa3);
}
template <int VAR> __device__ __forceinline__ void attn_map(const int MAP, const bf16_t* __restrict__ Qb, const bf16_t* __restrict__ Kh, const bf16_t* __restrict__ Vh, float* O1b, bf16_t* Oab,
                                         const float* subg, float lam, int seq, char* lds) {
  const int tid = threadIdx.x, lane = tid & 63, r32 = lane & 31, hi = lane >> 5; const int wid = __builtin_amdgcn_readfirstlane(tid >> 6);
  char* V_lds = lds; char* K_lds = lds + NSLOT * SHM_V;
  float* ws = (float*)(lds + NSLOT * (SHM_V + SHM_K)) + wid * 64; float* li_l = ws; float* al_l = ws + 32;
  float m_reg = -1e30f, l_reg = 0; f32x16 o[4] = {}; bf16x8 qr[4];
  const bf16_t* Qw = Qb + (long)(wid * QBLK + r32) * LD + hi * 8;
  const bf16_t* ksrc; const bf16_t* vsrc0; const bf16_t* vsrc1;
  { const int p = wid * 64 + lane, row = p >> 3, ch = (p & 7) ^ ((row >> 1) & 7); ksrc = Kh + (long)row * LD + ch * 8; }
  { const int p = (2 * wid) * 64 + lane, sub = p >> 5, q = p & 31, kk = (sub >> 2) * 8 + (q >> 2), c = (sub & 3) * 32 + (q & 3) * 8, k = (kk & ~0xC) | ((kk & 4) << 1) | ((kk & 8) >> 1); vsrc0 = Vh + (long)k * LD + c; }
  { const int p = (2 * wid + 1) * 64 + lane, sub = p >> 5, q = p & 31, kk = (sub >> 2) * 8 + (q >> 2), c = (sub & 3) * 32 + (q & 3) * 8, k = (kk & ~0xC) | ((kk & 4) << 1) | ((kk & 8) >> 1); vsrc1 = Vh + (long)k * LD + c; }
  typedef __attribute__((address_space(3))) unsigned ldsu;
  ldsu* kdst = (ldsu*)(__attribute__((address_space(3))) char*)(K_lds) + wid * 256;
  ldsu* vdst = (ldsu*)(__attribute__((address_space(3))) char*)(V_lds) + wid * 512;
  const int NT = seq / KVBLK, TL = NT - 1;
#define DMA_K(t, slot) do { if constexpr (!AV_NOSTAGE(VAR)) { const int t_ = (t) < TL ? (t) : TL; \
    __builtin_amdgcn_global_load_lds((const unsigned*)(ksrc + (long)t_ * KVBLK * LD), kdst + (slot) * (int)(SHM_K / 4), 16, 0, 0); } } while (0)
#define DMA_V(t, slot) do { if constexpr (!AV_NOSTAGE(VAR)) { const int t_ = (t) < TL ? (t) : TL; \
    __builtin_amdgcn_global_load_lds((const unsigned*)(vsrc0 + (long)t_ * KVBLK * LD), vdst + (slot) * (int)(SHM_V / 4), 16, 0, 0); \
    __builtin_amdgcn_global_load_lds((const unsigned*)(vsrc1 + (long)t_ * KVBLK * LD), vdst + (slot) * (int)(SHM_V / 4) + 256, 16, 0, 0); } } while (0)
#define TILE_BAR(n) do { asm volatile("s_waitcnt vmcnt(" #n ") lgkmcnt(0)" ::: "memory"); if constexpr (!AV_NOSYNC(VAR)) __builtin_amdgcn_s_barrier(); asm volatile("" ::: "memory"); } while (0)
#define RESC(a) do { if (__any((a) < 1.f)) { if (hi == 0) al_l[r32] = (a); asm volatile("s_waitcnt lgkmcnt(0)" ::: "memory"); \
    _Pragma("unroll") for (int d = 0; d < 4; ++d) _Pragma("unroll") for (int r = 0; r < 16; ++r) o[d][r] *= al_l[crow(r, hi)]; } } while (0)
  DMA_K(0, 0); DMA_V(0, 0); DMA_K(1, 1);
#pragma unroll
  for (int d0 = 0; d0 < 4; ++d0) qr[d0] = *reinterpret_cast<const bf16x8*>(Qw + d0 * 16);
  const int vb0 = (int)(uintptr_t)V_lds + v_rd_base(lane);
  f32x16 pA0, pA1, pB0, pB1; float mnA, alA, alB; bf16x8 pa0, pa1, pa2, pa3;
  TILE_BAR(0);
  int kc = 0, vp = 2;
#define NEXT3(x) ((x) == 2 ? 0 : (x) + 1)
#define PREV3(x) ((x) == 0 ? 2 : (x) - 1)
  DMA_K(2, PREV3(kc)); DMA_V(1, NEXT3(NEXT3(vp)));
  qkt<VAR>(pA0, pA1, K_lds + kc * SHM_K, qr, r32, hi); partialSM(pA0, pA1, m_reg, mnA, alA);
  TILE_BAR(3); kc = NEXT3(kc); vp = NEXT3(vp);
  for (int j = 1; j + 1 < NT; j += 2) {
    DMA_K(j + 2, PREV3(kc)); DMA_V(j + 1, NEXT3(NEXT3(vp)));
    SBAR(); qkt<VAR>(pB0, pB1, K_lds + kc * SHM_K, qr, r32, hi);
    finishSM<VAR>(pA0, pA1, alA, l_reg, pa0, pa1, pa2, pa3); SBAR();
    pv_sm<VAR>(o, vb0 + vp * (int)SHM_V, pa0, pa1, pa2, pa3, pB0, pB1, m_reg, alB);
    RESC(alB); TILE_BAR(3); kc = NEXT3(kc); vp = NEXT3(vp);
    DMA_K(j + 3, PREV3(kc)); DMA_V(j + 2, NEXT3(NEXT3(vp)));
    SBAR(); qkt<VAR>(pA0, pA1, K_lds + kc * SHM_K, qr, r32, hi);
    finishSM<VAR>(pB0, pB1, alB, l_reg, pa0, pa1, pa2, pa3); SBAR();
    pv_sm<VAR>(o, vb0 + vp * (int)SHM_V, pa0, pa1, pa2, pa3, pA0, pA1, m_reg, alA);
    RESC(alA); TILE_BAR(3); kc = NEXT3(kc); vp = NEXT3(vp);
  }
  DMA_K(NT, PREV3(kc)); DMA_V(NT, NEXT3(NEXT3(vp)));
  SBAR(); qkt<VAR>(pB0, pB1, K_lds + kc * SHM_K, qr, r32, hi);
  finishSM<VAR>(pA0, pA1, alA, l_reg, pa0, pa1, pa2, pa3); SBAR();
  pv_sm<VAR>(o, vb0 + vp * (int)SHM_V, pa0, pa1, pa2, pa3, pB0, pB1, m_reg, alB);
  RESC(alB); TILE_BAR(3); vp = NEXT3(vp);
  finishSM<VAR>(pB0, pB1, alB, l_reg, pa0, pa1, pa2, pa3); SBAR();
  pv_d0<VAR>(o, vb0 + vp * (int)SHM_V, pa0, pa1, pa2, pa3);
  TILE_BAR(0);
  if (hi == 0) li_l[r32] = l_reg; asm volatile("s_waitcnt lgkmcnt(0)" ::: "memory");
  float rli[16];
#pragma unroll
  for (int r = 0; r < 16; ++r) rli[r] = __builtin_amdgcn_rcpf(li_l[crow(r, hi)]);
  int r32e = r32, hie = hi, wide = wid, lanee = lane; asm volatile("" : "+v"(r32e), "+v"(hie), "+v"(wide), "+v"(lanee));
  u32x4* o1l = (u32x4*)(lds + SHM_ATTN) + wide * 512 + lanee;
  if (MAP == 0) {
#pragma unroll
    for (int d0 = 0; d0 < 4; ++d0)
#pragma unroll
      for (int g = 0; g < 2; ++g) { u32x4 w;
#pragma unroll
        for (int q = 0; q < 4; ++q) { const int r = g * 8 + 2 * q; w[q] = cvtpk(o[d0][r] * rli[r], o[d0][r + 1] * rli[r + 1]); }
        o1l[(d0 * 2 + g) * 64] = w; }
  } else {
    float sg[4];
#pragma unroll
    for (int d0 = 0; d0 < 4; ++d0) sg[d0] = subg[d0 * 32 + r32e] * (1.f - LAM_INIT);
    bf16_t* Oa = Oab + (long)(wide * QBLK) * LD;
#pragma unroll
    for (int d0 = 0; d0 < 4; ++d0)
#pragma unroll
      for (int g = 0; g < 2; ++g) { const u32x4 w = o1l[(d0 * 2 + g) * 64];
#pragma unroll
        for (int q = 0; q < 4; ++q) { const int r = g * 8 + 2 * q;
          o[d0][r] = __uint_as_float(w[q] << 16) - lam * (o[d0][r] * rli[r]); o[d0][r + 1] = __uint_as_float(w[q] & 0xffff0000u) - lam * (o[d0][r + 1] * rli[r + 1]); } }
#pragma unroll
    for (int rg = 0; rg < 4; ++rg) {
      float ss[4];
#pragma unroll
      for (int q = 0; q < 4; ++q) { const int r = rg * 4 + q; float s_ = 0.f;
#pragma unroll
        for (int d0 = 0; d0 < 4; ++d0) s_ += o[d0][r] * o[d0][r];
        ss[q] = s_; }
#pragma unroll
      for (int sft = 1; sft < 32; sft <<= 1)
#pragma unroll
        for (int q = 0; q < 4; ++q) ss[q] += __shfl_xor(ss[q], sft);
#pragma unroll
      for (int q = 0; q < 4; ++q) { const int r = rg * 4 + q, orow = crow(r, hie); const float rs = __builtin_amdgcn_rsqf(ss[q] * (1.f / 128.f) + EPS);
#pragma unroll
        for (int d0 = 0; d0 < 4; ++d0) Oa[(long)orow * LD + d0 * 32 + r32e] = (bf16_t)f2bf(o[d0][r] * rs * sg[d0]); }
    }
  }
#undef DMA_K
#undef DMA_V
#undef TILE_BAR
#undef NEXT3
#undef PREV3
#undef RESC
}
#undef SBAR
}

constexpr int CW_TMO = 0, CW_CODE = 1;
constexpr int CW_BAR = 4096;
#define XB_TMO      128
#define XB_XCNT(j)  (256  + 64 * (j))
#define XB_XSUB(j)  (1280 + 64 * (j))
#define XB_XGEN(j)  (2304 + 64 * (j))
#define XB_TOP      3328
#define XB_TOPGEN   3392
#define XCD_BAR_WORDS 3456
#define XB_SPIN_CAP (1u << 18)
__device__ __forceinline__ unsigned xb_ld(unsigned* p)              { return __hip_atomic_load(p, __ATOMIC_RELAXED, __HIP_MEMORY_SCOPE_AGENT); }
__device__ __forceinline__ unsigned xb_add(unsigned* p, unsigned v) { return __hip_atomic_fetch_add(p, v, __ATOMIC_RELAXED, __HIP_MEMORY_SCOPE_AGENT); }
__device__ __forceinline__ unsigned xb_xcc_id() { return (unsigned)__builtin_amdgcn_s_getreg((3 << 11) | 20) & 0xFu; }
#define XB_SPIN(cond, bar) do { unsigned _sp = 0; while (cond) { __builtin_amdgcn_s_sleep(1); \
    if ((++_sp & 255u) == 0u) { if (xb_ld(&(bar)[XB_TMO])) break; if (_sp > XB_SPIN_CAP) { atomicAdd(&(bar)[XB_TMO], 1u); break; } } } } while (0)
struct XcdBarrier { unsigned* bar; unsigned x; volatile LAS unsigned* st; };
__device__ __forceinline__ XcdBarrier xcd_barrier_post(unsigned* bar, volatile LAS unsigned* st) {
    XcdBarrier b; b.bar = bar; b.x = xb_xcc_id(); b.st = st;
    if (threadIdx.x == 0) (void)xb_add(&bar[XB_XCNT(b.x)], 1u);
    return b;
}
__device__ __forceinline__ void xcd_barrier_complete(unsigned* bar, unsigned x, unsigned& nloc, unsigned& nx) {
    const unsigned G = gridDim.x * gridDim.y * gridDim.z;
    unsigned sum, cnt, mine, sp = 0u;
    for (;;) {
        sum = 0u; cnt = 0u; mine = 0u;
#pragma unroll
        for (unsigned j = 0; j < 16; ++j) { const unsigned c = xb_ld(&bar[XB_XCNT(j)]); sum += c; cnt += (c > 0u) ? 1u : 0u; mine = (j == x) ? c : mine; }
        if (sum == G) break;
        __builtin_amdgcn_s_sleep(1);
        if ((++sp & 255u) == 0u) { if (xb_ld(&bar[XB_TMO])) break; if (sp > XB_SPIN_CAP) { atomicAdd(&bar[XB_TMO], 1u); break; } }
    }
    nloc = mine > 0u ? mine : 1u; nx = cnt > 0u ? cnt : 1u;
}
__device__ __forceinline__ void xcd_barrier(const XcdBarrier& b) {
    asm volatile("s_waitcnt vmcnt(0)" ::: "memory");
    __syncthreads();
    if (threadIdx.x == 0) {
        unsigned* bar = b.bar;
        __builtin_amdgcn_s_waitcnt(0);
        unsigned nloc = b.st[0], nx = b.st[1];
        if (nloc == 0u) { xcd_barrier_complete(bar, b.x, nloc, nx); b.st[0] = nloc; b.st[1] = nx; }
        const unsigned old = xb_add(&bar[XB_XSUB(b.x)], 1u);
        __builtin_amdgcn_fence(__ATOMIC_ACQUIRE, "agent");
        const unsigned gen = old / nloc;
        if (old + 1u == (gen + 1u) * nloc) {
            __builtin_amdgcn_fence(__ATOMIC_RELEASE, "agent");
            asm volatile("s_waitcnt vmcnt(0)" ::: "memory");
            const unsigned og = xb_add(&bar[XB_TOP], 1u);
            const unsigned tg = og / nx;
            if (og + 1u == (tg + 1u) * nx) xb_add(&bar[XB_TOPGEN], 1u);
            else XB_SPIN(xb_ld(&bar[XB_TOPGEN]) == tg, bar);
            xb_add(&bar[XB_XGEN(b.x)], 1u);
            asm volatile("s_waitcnt vmcnt(0)" ::: "memory");
        } else {
            XB_SPIN(xb_ld(&bar[XB_XGEN(b.x)]) == gen, bar);
            asm volatile("s_waitcnt vmcnt(0)" ::: "memory");
        }
    }
    __syncthreads();
}

constexpr int NWAVES = 8;
struct Args { const float* in[23]; float* out; unsigned char* ws; int ph_lo, ph_hi, li, pad; };
struct Frame {
    LAS unsigned char* lds;
    int tid, lane, wave, vcu, G;
    unsigned char* ws;
};

__device__ __forceinline__ void transpose_item(const float* W, int K, int N, bf16_t* WT, int k0, int n0, int rowbase, LAS float* scr, int lane) {
    float tv[32];
    const float* wp = W + (size_t)(k0 + (lane >> 5)) * N + n0 + (lane & 31);
#pragma unroll
    for (int i = 0; i < 32; ++i) tv[i] = __builtin_nontemporal_load(wp + (size_t)(2 * i) * N);
#pragma unroll
    for (int i = 0; i < 32; ++i) scr[(2 * i + (lane >> 5)) * 33 + (lane & 31)] = tv[i];
    LDS_WAIT(); asm volatile("" ::: "memory");
    const int c = lane & 7;
#pragma unroll
    for (int j = 0; j < 4; ++j) { const int n = (lane >> 3) + 8 * j; const LAS float* s = scr + (8 * c) * 33 + n;
        v4u o; o.x = pk2(s[0 * 33], s[1 * 33]); o.y = pk2(s[2 * 33], s[3 * 33]); o.z = pk2(s[4 * 33], s[5 * 33]); o.w = pk2(s[6 * 33], s[7 * 33]);
        *(GAS v4u*)(WT + (size_t)(rowbase + n) * K + k0 + 8 * c) = o; }
    LDS_WAIT(); asm volatile("" ::: "memory");
}

constexpr int FP8_SCR_STRIDE = 64 * 33 * 4;
__device__ __forceinline__ void transpose_item_fp8(const float* W, int K, int N, unsigned char* WT, int k0, int n0, int rowbase, LAS float* scrf, int lane, const float wsc = 16.f) {
    LAS unsigned* scr = (LAS unsigned*)scrf;
    const int l5 = lane & 31, lh = lane >> 5;
    const float* wp = W + (size_t)(k0 + 4 * lh) * N + n0 + 2 * l5;
    f32x2 tv[2][8][4];
#pragma unroll
    for (int s_ = 0; s_ < 2; ++s_)
#pragma unroll
        for (int t = 0; t < 8; ++t)
#pragma unroll
            for (int j = 0; j < 4; ++j) tv[s_][t][j] = __builtin_nontemporal_load((const f32x2*)(wp + (size_t)(64 * s_ + 8 * t + j) * N));
#pragma unroll
    for (int s_ = 0; s_ < 2; ++s_)
#pragma unroll
        for (int t = 0; t < 8; ++t)
#pragma unroll
            for (int c = 0; c < 2; ++c)
                scr[(2 * l5 + c) * 33 + 16 * s_ + 2 * t + lh] = pk_fp8x4(wsc * tv[s_][t][0][c], wsc * tv[s_][t][1][c], wsc * tv[s_][t][2][c], wsc * tv[s_][t][3][c]);
    LDS_WAIT(); asm volatile("" ::: "memory");
    const int c8 = lane & 7;
#pragma unroll
    for (int j = 0; j < 8; ++j) { const int n = (lane >> 3) + 8 * j; const LAS unsigned* sp = scr + n * 33 + 4 * c8;
        v4u o; o.x = sp[0]; o.y = sp[1]; o.z = sp[2]; o.w = sp[3];
        *(GAS v4u*)(WT + (size_t)(rowbase + n) * K + k0 + 16 * c8) = o; }
    LDS_WAIT(); asm volatile("" ::: "memory");
}
__device__ __forceinline__ void p0_prologue(Frame& F, const Args& a) {
    float* mods = (float*)(F.ws + WS_MODS);
    for (int item = blockIdx.x; item < NMOD / 64; item += F.G) {
        LAS float* sil = (LAS float*)F.lds; LAS float* red = sil + 9 * DM;
        for (int i = F.tid; i < 9 * DM; i += 512) { const float v = i < 8 * DM ? a.in[1][i] : a.in[3][i - 8 * DM]; sil[i] = v * sigmoidf_(v); }
        __syncthreads();
        const float* wa = a.in[6] + 64 * item + F.lane; float acc[9];
#pragma unroll
        for (int b = 0; b < 9; ++b) acc[b] = 0.f;
        const int kb = F.wave * 128;
#pragma unroll 8
        for (int k = kb; k < kb + 128; ++k) { const float wv = wa[(size_t)k * NMOD];
#pragma unroll
            for (int b = 0; b < 9; ++b) acc[b] += sil[b * DM + k] * wv; }
#pragma unroll
        for (int b = 0; b < 9; ++b) red[(F.wave * 9 + b) * 64 + F.lane] = acc[b];
        __syncthreads();
        for (int i = F.tid; i < 9 * 64; i += 512) { const int b = i >> 6, l = i & 63; float s = 0.f;
#pragma unroll
            for (int w = 0; w < 8; ++w) s += red[(w * 9 + b) * 64 + l];
            mods[(size_t)b * NMOD + 64 * item + l] = s + a.in[7][64 * item + l]; }
        __syncthreads();
    }
    LAS float* scr = (LAS float*)(F.lds + F.wave * 16384);
    const int gw = F.vcu * NWAVES + F.wave, NGW = F.G * NWAVES;
    constexpr int I_IN = (DM / 64) * (8 * DM / 32), I_SQ = (DM / 64) * (DM / 32);
    for (int it = gw; it < I_IN + 3 * I_SQ; it += NGW) {
        if (it < I_IN) { const int nblk = 8 * DM / 32, kb = it / nblk, nb = it % nblk, c0 = 32 * nb, part = c0 >> 10, j0 = c0 & 1023;
            const int rb = part == 0 ? (j0 >> 7) * 256 + (j0 & 127) : part == 2 ? (j0 >> 7) * 256 + 128 + (j0 & 127) : part == 1 ? 2048 + j0 : c0;
            transpose_item(a.in[8], DM, 8 * DM, (bf16_t*)(F.ws + WS_WIN), 64 * kb, c0, rb, scr, F.lane); }
        else { const int r = it - I_IN, which = r / I_SQ, q = r % I_SQ, kb = q / 32, nb = q % 32;
            const float* W = which == 0 ? a.in[10] : which == 1 ? a.in[16] : a.in[17];
            bf16_t* WT = (bf16_t*)(F.ws + (which == 0 ? WS_WC : which == 1 ? WS_WO : WS_WOUT));
            transpose_item(W, DM, DM, WT, 64 * kb, 32 * nb, 32 * nb, scr, F.lane); }
    }
}
__device__ __forceinline__ void p1_norm(Frame& F, const Args& a) {
    const float* mods = (const float*)(F.ws + WS_MODS); bf16_t* A1 = (bf16_t*)(F.ws + WS_A1);
    const int gw = F.vcu * NWAVES + F.wave, NGW = F.G * NWAVES;
    for (int row = gw; row < MA; row += NGW) {
        const float* xr = row < MX ? a.in[0] + (size_t)row * DM : a.in[2] + (size_t)(row - MX) * DM;
        const int b = row < MX ? row >> 11 : 8;
        const f32x4* xv = (const f32x4*)xr + F.lane; f32x4 v[4]; float s = 0.f;
#pragma unroll
        for (int j = 0; j < 4; ++j) { v[j] = xv[64 * j]; s += (v[j].x * v[j].x + v[j].y * v[j].y) + (v[j].z * v[j].z + v[j].w * v[j].w); }
        const float rstd = __builtin_amdgcn_rsqf(wave_sum(s) * (1.f / DM) + EPS);
        const f32x4* gv = (const f32x4*)a.in[4] + F.lane; const f32x4* shv = (const f32x4*)(mods + (size_t)b * NMOD) + F.lane; const f32x4* scv = (const f32x4*)(mods + (size_t)b * NMOD + DM) + F.lane;
        v2u* o8 = (v2u*)(A1 + (size_t)row * DM) + F.lane;
#pragma unroll
        for (int j = 0; j < 4; ++j) { const f32x4 y = (v[j] * rstd * gv[64 * j]) * (scv[64 * j] + 1.f) + shv[64 * j];
            v2u w; w.x = pk2(y.x, y.y); w.y = pk2(y.z, y.w); o8[64 * j] = w; }
    }
}
__device__ __forceinline__ void p3_conv(Frame& F, const Args& a) {
    const bf16_t* Z = (const bf16_t*)(F.ws + WS_Z); const bf16_t* GB = (const bf16_t*)(F.ws + WS_GB); bf16_t* AC = (bf16_t*)(F.ws + WS_A1);
    const int gw = F.vcu * NWAVES + F.wave, NGW = F.G * NWAVES;
    const float* cw = a.in[9];
    for (int grp = gw; grp < MX / 8; grp += NGW) {
#pragma unroll
        for (int half = 0; half < 2; ++half) {
            const int col = half * 512 + F.lane * 8;
            f32x4 w0[2], w1[2], w2[2];
#pragma unroll
            for (int i = 0; i < 2; ++i) { w0[i] = *(const f32x4*)(cw + col + 4 * i); w1[i] = *(const f32x4*)(cw + DM + col + 4 * i); w2[i] = *(const f32x4*)(cw + 2 * DM + col + 4 * i); }
            const int r0 = grp * 8; f32x4 zp[2], zc[2], zn[2];
            if ((r0 & (SEQ - 1)) == 0) { zp[0] = (f32x4){0.f, 0.f, 0.f, 0.f}; zp[1] = zp[0]; } else pg8::unpack8(*(const v4u*)(Z + (size_t)(r0 - 1) * DM + col), zp[0], zp[1]);
            pg8::unpack8(*(const v4u*)(Z + (size_t)r0 * DM + col), zc[0], zc[1]);
#pragma unroll
            for (int r = 0; r < 8; ++r) { const int row = r0 + r;
                if ((row & (SEQ - 1)) == SEQ - 1) { zn[0] = (f32x4){0.f, 0.f, 0.f, 0.f}; zn[1] = zn[0]; } else pg8::unpack8(*(const v4u*)(Z + (size_t)(row + 1) * DM + col), zn[0], zn[1]);
                f32x4 g0, g1; pg8::unpack8(*(const v4u*)(GB + (size_t)row * DM + col), g0, g1);
                const f32x4 y0 = g0 * (zp[0] * w0[0] + zc[0] * w1[0] + zn[0] * w2[0]), y1 = g1 * (zp[1] * w0[1] + zc[1] * w1[1] + zn[1] * w2[1]);
                *(v4u*)(AC + (size_t)row * DM + col) = pg8::pack8(y0, y1);
                zp[0] = zc[0]; zp[1] = zc[1]; zc[0] = zn[0]; zc[1] = zn[1]; }
        }
    }
}
template <int VAR> __device__ __forceinline__ void p3_attn(Frame& F, const Args& a, char* lds) {
    float s1 = 0.f, s2 = 0.f;
    for (int i = 0; i < 64; ++i) { s1 += a.in[11][i] * a.in[12][i]; s2 += a.in[13][i] * a.in[14][i]; }
    const float lam = __expf(s1) - __expf(s2) + LAM_INIT;
    const bf16_t* Q = (const bf16_t*)(F.ws + WS_Q); const bf16_t* KA = (const bf16_t*)(F.ws + WS_KALL); const bf16_t* VA = (const bf16_t*)(F.ws + WS_VALL);
    float* O1 = (float*)(F.ws + WS_O1); bf16_t* OA = (bf16_t*)(F.ws + (VAR < 0 ? WS_OATT : WS_MERGED));
    for (int it = 2 * F.vcu; it < 2 * NB * NH * 8; it += 2 * F.G + ((it & 1) ? -1 : 1) - ((it & 1) ? 0 : 2 * F.G)) {
        const int u = it >> 1, map = it & 1;
        const int bh = u >> 3, qb = u & 7, b = bh >> 3, h = bh & 7;
        const size_t qrow = (size_t)b * SEQ + qb * 256, krow = (size_t)b * SKV;
        att::attn_map<VAR>(map, Q + qrow * DM + h * 128 + map * 64, KA + krow * DM + h * 128 + map * 64, VA + krow * DM + h * 128, O1 + qrow * DM + h * 128, OA + qrow * DM + h * 128, a.in[15], lam, SKV, lds);
    }
}
__device__ __forceinline__ void p6_norm_router(Frame& F, const Args& a) {
    const float* mods = (const float*)(F.ws + WS_MODS); unsigned char* HX = (unsigned char*)(F.ws + WS_HX2);   float* aff = (float*)(F.ws + WS_AFF);
    LAS float* wrT = (LAS float*)F.lds;
    for (int i = F.tid; i < DM * NE; i += 512) wrT[(i & 15) * DM + (i >> 4)] = a.in[18][i];
    __syncthreads();
    const int gw = F.vcu * NWAVES + F.wave, NGW = F.G * NWAVES;
    const f32x4* gv = (const f32x4*)a.in[5] + F.lane;
    const bool b5 = F.lane & 32, b4 = F.lane & 16, b3 = F.lane & 8, b2 = F.lane & 4;
    for (int grp = gw; grp < MX / 8; grp += NGW) {
        const int b = (grp * 8) >> 11;
        const f32x4* shv = (const f32x4*)(mods + (size_t)b * NMOD + 3 * DM) + F.lane; const f32x4* scv = (const f32x4*)(mods + (size_t)b * NMOD + 4 * DM) + F.lane; f32x4 sh[4], sc[4];
#pragma unroll
        for (int j = 0; j < 4; ++j) { sh[j] = shv[64 * j]; sc[j] = (scv[64 * j] + 1.f) * gv[64 * j]; }
        const bf16_t* MIX = (const bf16_t*)(F.ws + WS_MIX);
        f32x4 vn[2][4]; v2u mn_[2][4];
#pragma unroll
        for (int t = 0; t < 2; ++t) { const f32x4* xv = (const f32x4*)(a.in[0] + (size_t)(grp * 8 + t) * DM) + F.lane; const v2u* mv = (const v2u*)(MIX + (size_t)(grp * 8 + t) * DM) + F.lane;
#pragma unroll
          for (int j = 0; j < 4; ++j) { vn[t][j] = xv[64 * j]; mn_[t][j] = mv[64 * j]; } }
#pragma unroll 1
        for (int rp = 0; rp < 4; ++rp) { const int row = grp * 8 + 2 * rp;
            f32x4 v[2][4]; float s[2] = {0.f, 0.f};
#pragma unroll
            for (int t = 0; t < 2; ++t)
#pragma unroll
                for (int j = 0; j < 4; ++j) { v[t][j] = vn[t][j] + (f32x4){bf_lo(mn_[t][j].x), bf_hi(mn_[t][j].x), bf_lo(mn_[t][j].y), bf_hi(mn_[t][j].y)};
                    s[t] += (v[t][j].x * v[t][j].x + v[t][j].y * v[t][j].y) + (v[t][j].z * v[t][j].z + v[t][j].w * v[t][j].w); }
            if (rp < 3) {
#pragma unroll
                for (int t = 0; t < 2; ++t) { const f32x4* xv = (const f32x4*)(a.in[0] + (size_t)(row + 2 + t) * DM) + F.lane; const v2u* mv = (const v2u*)(MIX + (size_t)(row + 2 + t) * DM) + F.lane;
#pragma unroll
                    for (int j = 0; j < 4; ++j) { vn[t][j] = xv[64 * j]; mn_[t][j] = mv[64 * j]; } } }
#pragma unroll
            for (int t = 0; t < 2; ++t) { const float rstd = __builtin_amdgcn_rsqf(wave_sum(s[t]) * (1.f / DM) + EPS);
                unsigned* o8 = (unsigned*)(HX + (size_t)(row + t) * DM) + F.lane;
#pragma unroll
                for (int j = 0; j < 4; ++j) { v[t][j] = (v[t][j] * rstd) * sc[j] + sh[j];
                    o8[64 * j] = pk_fp8x4(v[t][j].x, v[t][j].y, v[t][j].z, v[t][j].w); } }
            f32x2 vv[16];
#pragma unroll
            for (int j = 0; j < 4; ++j)
#pragma unroll
                for (int c = 0; c < 4; ++c) vv[4 * j + c] = (f32x2){v[0][j][c], v[1][j][c]};
            float p[2][NE];
#pragma unroll
            for (int eg = 0; eg < NE; eg += 2) {
#pragma unroll
                for (int e = eg; e < eg + 2; ++e) { f32x2 q = {0.f, 0.f};
#pragma unroll
                    for (int j = 0; j < 4; ++j) { const f32x4 w = *(const LAS f32x4*)(wrT + e * DM + 256 * j + 4 * F.lane);
#pragma unroll
                        for (int c = 0; c < 4; ++c) q = __builtin_elementwise_fma(vv[4 * j + c], (f32x2){w[c], w[c]}, q); }
                    p[0][e] = q.x; p[1][e] = q.y; }
                asm volatile("" ::: "memory"); }
#pragma unroll
            for (int t = 0; t < 2; ++t) {
                float q8[8], q4[4], q2[2], q1;
#pragma unroll
                for (int i = 0; i < 8; ++i) { const float keep = b5 ? p[t][i + 8] : p[t][i], send = b5 ? p[t][i] : p[t][i + 8]; q8[i] = keep + __shfl_xor(send, 32); }
#pragma unroll
                for (int i = 0; i < 4; ++i) { const float keep = b4 ? q8[i + 4] : q8[i], send = b4 ? q8[i] : q8[i + 4]; q4[i] = keep + __shfl_xor(send, 16); }
#pragma unroll
                for (int i = 0; i < 2; ++i) { const float keep = b3 ? q4[i + 2] : q4[i], send = b3 ? q4[i] : q4[i + 2]; q2[i] = keep + __shfl_xor(send, 8); }
                { const float keep = b2 ? q2[1] : q2[0], send = b2 ? q2[0] : q2[1]; q1 = keep + __shfl_xor(send, 4); }
                q1 += __shfl_xor(q1, 1); q1 += __shfl_xor(q1, 2);
                float mx = q1;
#pragma unroll
                for (int sft = 4; sft < 64; sft <<= 1) mx = fmaxf(mx, __shfl_xor(mx, sft));
                const float ex = __expf(q1 - mx); float den = ex;
#pragma unroll
                for (int sft = 4; sft < 64; sft <<= 1) den += __shfl_xor(den, sft);
                if ((F.lane & 3) == 0) aff[(size_t)(row + t) * NE + (F.lane >> 2)] = ex / den;
            }
        }
    }
    __syncthreads();
}
__device__ __forceinline__ void p7_topk_item(Frame& F, int item) {
    const int b = item >> 4, e = item & 15;
    const float* aff = (const float*)(F.ws + WS_AFF); int* slot = (int*)(F.ws + WS_SLOT); float* gate = (float*)(F.ws + WS_GATE);
    LAS unsigned long long* key = (LAS unsigned long long*)F.lds;
    LAS int* sel = (LAS int*)(F.lds + 16384);
    for (int i = F.tid; i < SEQ; i += 512) { const float v = aff[((size_t)b * SEQ + i) * NE + e];
        key[i] = ((unsigned long long)__builtin_bit_cast(unsigned, v) << 32) | (unsigned)(SEQ - 1 - i); sel[i] = -1; }
    __syncthreads();
    for (int k = 2; k <= SEQ; k <<= 1)
        for (int j = k >> 1; j > 0; j >>= 1) {
            for (int t = F.tid; t < SEQ / 2; t += 512) { const int i = ((t & ~(j - 1)) << 1) | (t & (j - 1)), p = i | j;
                const unsigned long long x = key[i], y = key[p]; const bool desc = (i & k) == 0;
                if (desc ? (x < y) : (x > y)) { key[i] = y; key[p] = x; } }
            __syncthreads();
        }
    const int xsrow0 = (e * NB + b) * CAP; int* gidx = (int*)(F.ws + WS_GIDX);
    if (F.tid < CAP) { const unsigned long long kk = key[F.tid]; const int idx = SEQ - 1 - (int)(unsigned)kk; sel[idx] = F.tid; gate[xsrow0 + F.tid] = __builtin_bit_cast(float, (unsigned)(kk >> 32)); gidx[xsrow0 + F.tid] = b * SEQ + idx; }
    __syncthreads();
    for (int i = F.tid; i < SEQ; i += 512) slot[(size_t)(b * NE + e) * SEQ + i] = sel[i];
    __syncthreads();
}
constexpr int N_WGU_ITEMS = NE * 512, N_WD_ITEMS = NE * 256, WD_EARLY_PER_WAVE = 2, WD_EARLY = 192 * NWAVES * WD_EARLY_PER_WAVE;
__device__ __forceinline__ void wgu_item(Frame& F, const Args& a, int it, LAS float* scr) {
    const int e = it >> 9, r = it & 511, which = r >> 8, q = r & 255, kb = q >> 5, nb = q & 31, n0 = 64 * nb;
    transpose_item_fp8(a.in[19 + which] + (size_t)e * DM * FH, DM, FH, (unsigned char*)(F.ws + WS_WGU), 128 * kb, n0, e * 4096 + (n0 >> 7) * 256 + (n0 & 127) + which * 128, scr, F.lane,
                       which == 0 ? -16.f * 1.4426950408889634f : -16.f / 1.4426950408889634f);
}
__device__ __forceinline__ void wd_item(Frame& F, const Args& a, int w, LAS float* scr) {
    const int e = w >> 8, q = w & 255, kb = q >> 4, nb = q & 15;
    transpose_item_fp8(a.in[21] + (size_t)e * FH * DM, FH, DM, (unsigned char*)(F.ws + WS_WD), 128 * kb, 64 * nb, e * DM + 64 * nb, scr, F.lane);
}
__device__ __forceinline__ void p7_moe_weight_item(Frame& F, const Args& a, int it, int wd0, LAS float* scr) {
    if (it < N_WGU_ITEMS) wgu_item(F, a, it, scr); else wd_item(F, a, wd0 + (it - N_WGU_ITEMS), scr);
}
constexpr int NIT7 = N_WGU_ITEMS + N_WD_ITEMS - WD_EARLY, Y3 = 3, N3 = 256 * NWAVES * Y3, X7 = 3;
static_assert(N3 <= NIT7 && N3 + 128 * NWAVES * X7 >= NIT7, "MoE weight item split");
__device__ __forceinline__ void p3_weight_share(Frame& F, const Args& a) {
    if (F.G != 256) return;
    LAS float* scr = (LAS float*)(F.lds + F.wave * FP8_SCR_STRIDE);
    const int start = F.vcu * NWAVES * Y3 + F.wave;
    for (int it = start; it < start + NWAVES * Y3; it += NWAVES) p7_moe_weight_item(F, a, it, WD_EARLY, scr);
}
__device__ __forceinline__ void p7_topk_weights(Frame& F, const Args& a) {
    LAS float* scr = (LAS float*)(F.lds + F.wave * FP8_SCR_STRIDE);
    if (F.G == 256) {
        if (!(F.vcu & 1)) p7_topk_item(F, F.vcu >> 1);
        else { const int start = N3 + (F.vcu >> 1) * NWAVES * X7 + F.wave;
            for (int it = start; it < start + NWAVES * X7 && it < NIT7; it += NWAVES) p7_moe_weight_item(F, a, it, WD_EARLY, scr); }
    } else {
        for (int item = F.vcu; item < NB * NE; item += F.G) p7_topk_item(F, item);
        const int gw = F.vcu * NWAVES + F.wave, NGW = F.G * NWAVES;
        for (int it = gw; it < N_WGU_ITEMS + N_WD_ITEMS; it += NGW) p7_moe_weight_item(F, a, it, 0, scr);
    }
}
template <bool DRY> __device__ __forceinline__ void p10_final(Frame& F, const Args& a) {
    const float* mods = (const float*)(F.ws + WS_MODS); const int* slot = (const int*)(F.ws + WS_SLOT); const bf16_t* YG = (const bf16_t*)(F.ws + WS_YG);
    const int gw = F.vcu * NWAVES + F.wave, NGW = F.G * NWAVES;
    const f32x4* fgv = (const f32x4*)a.in[22] + F.lane; f32x4 fg[4];
#pragma unroll
    for (int j = 0; j < 4; ++j) fg[j] = fgv[64 * j];
    for (int grp = gw; grp < MX / 8; grp += NGW) {
        const int row0 = grp * 8, b = row0 >> 11, t0 = row0 & (SEQ - 1);
        const f32x4* g2v = (const f32x4*)(mods + (size_t)b * NMOD + 5 * DM) + F.lane; f32x4 g2[4];
#pragma unroll
        for (int j = 0; j < 4; ++j) g2[j] = g2v[64 * j];
        const int sl0 = slot[(size_t)(b * NE + (F.lane & 15)) * SEQ + t0 + (F.lane >> 4)], sl1 = slot[(size_t)(b * NE + (F.lane & 15)) * SEQ + t0 + 4 + (F.lane >> 4)];
#pragma unroll 2
        for (int r = 0; r < 8; ++r) { const int row = row0 + r;
            const int sv = r < 4 ? sl0 : sl1;
            unsigned long long bal = __ballot(sv >= 0); unsigned mask = (unsigned)(bal >> (16 * (r & 3))) & 0xffffu;
            f32x4 acc[4];
#pragma unroll
            for (int j = 0; j < 4; ++j) acc[j] = (f32x4){0.f, 0.f, 0.f, 0.f};
            while (mask) {
                const v2u* yv[4]; float wgt[4];
#pragma unroll
                for (int i = 0; i < 4; ++i) { int e = 0, sidx = 0; wgt[i] = 0.f;
                    if (mask) { e = __builtin_ctz(mask); mask &= mask - 1; sidx = __builtin_amdgcn_readlane(sv, 16 * (r & 3) + e); wgt[i] = 1.f; }
                    yv[i] = (const v2u*)(YG + (size_t)((e * NB + b) * CAP + sidx) * DM) + F.lane; }
                v2u w[4][4];
#pragma unroll
                for (int i = 0; i < 4; ++i)
#pragma unroll
                    for (int j = 0; j < 4; ++j) w[i][j] = yv[i][64 * j];
#pragma unroll
                for (int i = 0; i < 4; ++i)
#pragma unroll
                    for (int j = 0; j < 4; ++j) acc[j] += (f32x4){bf_lo(w[i][j].x), bf_hi(w[i][j].x), bf_lo(w[i][j].y), bf_hi(w[i][j].y)} * wgt[i];
            }
            const f32x4* xin = (const f32x4*)(a.in[0] + (size_t)row * DM) + F.lane; const v2u* mv = (const v2u*)((const bf16_t*)(F.ws + WS_MIX) + (size_t)row * DM) + F.lane;
            f32x4* xv = (f32x4*)(a.out + (size_t)row * DM) + F.lane; f32x4 v[4]; float s = 0.f;
#pragma unroll
            for (int j = 0; j < 4; ++j) { const v2u mw = mv[64 * j]; v[j] = (xin[64 * j] + (f32x4){bf_lo(mw.x), bf_hi(mw.x), bf_lo(mw.y), bf_hi(mw.y)}) + g2[j] * acc[j]; s += (v[j].x * v[j].x + v[j].y * v[j].y) + (v[j].z * v[j].z + v[j].w * v[j].w); }
            const float rstd = __builtin_amdgcn_rsqf(wave_sum(s) * (1.f / DM) + EPS);
#pragma unroll
            for (int j = 0; j < 4; ++j) (DRY ? (f32x4*)((float*)(F.ws + WS_O1) + (size_t)row * DM) + F.lane : xv)[64 * j] = v[j] * rstd * fg[j];
        }
    }
}

__global__ void __launch_bounds__(NWAVES * 64, 2) mk_fwd(Args args) {
    extern __shared__ __attribute__((aligned(16))) unsigned char lds[];
    Frame F;
    F.lds = (LAS unsigned char*)lds;
    F.tid = threadIdx.x; F.lane = F.tid & 63; F.wave = __builtin_amdgcn_readfirstlane(F.tid >> 6);
    F.G = gridDim.x; { const int bx = blockIdx.x; F.vcu = (F.G % 8 == 0) ? (bx % 8) * (F.G / 8) + bx / 8 : bx; }
    F.ws = args.ws;
    volatile LAS unsigned* MISC = (volatile LAS unsigned*)(F.lds + MISC_OFF);
    gu32* ctl = (gu32*)(F.ws + WS_CTL);
    for (int u = F.tid; u < (LDS_BYTES - LDSCTL_OFF) / 4; u += NWAVES * 64) ((LAS unsigned*)(F.lds + LDSCTL_OFF))[u] = 0u;
    {
        LAS float* rope = (LAS float*)(F.lds + ROPE_OFF);
        for (int i = F.tid; i < 64 * 16; i += NWAVES * 64) { const int pos = i >> 4, f = i & 15;
            const float inv = __builtin_amdgcn_exp2f(-(float)f * (13.287712379549449f / 16.f)); const float ang = (float)pos * inv;
            rope[2 * i] = cosf(ang); rope[2 * i + 1] = sinf(ang); }
    }
    __syncthreads();
    const int lo = args.ph_lo, hi = args.ph_hi;
    XcdBarrier bar; bar.bar = (unsigned*)(ctl + CW_BAR) + args.li * XCD_BAR_WORDS; bar.x = 0; bar.st = nullptr;
    if (hi - lo > 1) bar = xcd_barrier_post((unsigned*)(ctl + CW_BAR) + args.li * XCD_BAR_WORDS, MISC + 8);
#ifndef MK_PHASES
#define MK_PHASES 0xfff
#endif
#define IN(k) ((((MK_PHASES) >> (k)) & 1) && lo <= (k) && (k) < hi)
#define SEAM(k) do { if (IN(k) && IN((k) + 1)) xcd_barrier(bar); } while (0)

    if (IN(0)) { p0_prologue(F, args); __syncthreads(); } SEAM(0);
    if (IN(1)) { p1_norm(F, args); } SEAM(1);
    if (IN(2)) {
        pg8::Gemm g{(const bf16_t*)(F.ws + WS_A1), (const bf16_t*)(F.ws + WS_WIN), DM}; pg8::OrdInProj S{F.G, (int)blockIdx.x};
        pg8::EpiInProj E{(bf16_t*)(F.ws + WS_Z), (bf16_t*)(F.ws + WS_GB), (bf16_t*)(F.ws + WS_Q), (bf16_t*)(F.ws + WS_KALL), (bf16_t*)(F.ws + WS_VALL), (bf16_t*)(F.ws + WS_S6), (bf16_t*)(F.ws + WS_S7),
                         (const LAS float*)(F.lds + ROPE_OFF)};
        pg8::gemm_phase<pg8::EpiInProj, pg8::OrdInProj, true, true>(F.lds, g, S, E);
        if (F.G == 256 && blockIdx.x >= 64) {
            LAS float* scr = (LAS float*)(F.lds + F.wave * FP8_SCR_STRIDE); const int w0 = ((int)blockIdx.x - 64) * NWAVES * WD_EARLY_PER_WAVE + F.wave;
            for (int w = w0; w < w0 + NWAVES * WD_EARLY_PER_WAVE; w += NWAVES) wd_item(F, args, w, scr);
        }
    } SEAM(2);
    if (IN(3)) { if (!(F.vcu & 1)) { p3_conv(F, args); p3_weight_share(F, args); __syncthreads(); } p3_attn<-1>(F, args, (char*)lds); if (F.vcu & 1) { __syncthreads(); p3_conv(F, args); p3_weight_share(F, args); } __syncthreads(); } SEAM(3);
    if (IN(4)) {
        constexpr size_t TB = (size_t)256 * DM * 2;
        static_assert(WS_A1 % TB == 0 && WS_OATT % TB == 0 && WS_WC % TB == 0 && WS_WO % TB == 0, "virtual tile indices need tile-aligned buffers");
        pg8::OrdMerge S; S.base.init(MX / 256, DM / 256, F.G, (int)blockIdx.x); S.pmA0 = (int)(WS_A1 / TB); S.pmA1 = (int)(WS_OATT / TB); S.pbB0 = (int)(WS_WC / TB); S.pbB1 = (int)(WS_WO / TB);
        pg8::Gemm g{(const bf16_t*)F.ws, (const bf16_t*)F.ws, DM};
        pg8::EpiMerge E{(const bf16_t*)(F.ws + WS_S6), (const bf16_t*)(F.ws + WS_S7), (bf16_t*)(F.ws + WS_MERGED)};
        pg8::gemm_phase<pg8::EpiMerge, pg8::OrdMerge, true, true>(F.lds, g, S, E);
    } SEAM(4);
    if (IN(5)) {
        pg8::OrdGrid S; S.init(MX / 256, DM / 256, F.G, (int)blockIdx.x);
        pg8::Gemm g{(const bf16_t*)(F.ws + WS_MERGED), (const bf16_t*)(F.ws + WS_WOUT), DM}; pg8::EpiOut E{(const float*)(F.ws + WS_MODS), (bf16_t*)(F.ws + WS_MIX)};
        pg8::gemm_phase<pg8::EpiOut, pg8::OrdGrid, false, true>(F.lds, g, S, E);
    } SEAM(5);
    if (IN(6)) { p6_norm_router(F, args); } SEAM(6);
    if (IN(7)) { p7_topk_weights(F, args); __syncthreads(); } SEAM(7);
    if (IN(8)) {
        LAS unsigned* gtab = (LAS unsigned*)(F.lds + GTAB_OFF); const int* gidx = (const int*)(F.ws + WS_GIDX);
        for (int i0 = 0; (long)i0 * F.G < 2048; i0 += 8) {
            pg8::OrdMoe<16> S{F.G, (int)blockIdx.x, i0, 8};
            for (int i = 0; i < 8; ++i) { pg8::Unit u; if (!S.next(i, u)) break; if (F.tid < 256) gtab[i * 256 + F.tid] = (unsigned)gidx[u.pm * 256 + F.tid] * (unsigned)DM; }
            __syncthreads();
            pg8::Gemm g{(const bf16_t*)(F.ws + WS_HX2), (const bf16_t*)(F.ws + WS_WGU), DM / 2}; pg8::EpiSwiGLU E{(unsigned char*)(F.ws + WS_H)};
            pg8::gemm_phase<pg8::EpiSwiGLU, pg8::OrdMoe<16>, true, true, true, true>(F.lds, g, S, E, (const LAS unsigned*)gtab);
            __syncthreads();
        }
    } SEAM(8);
    if (IN(9)) {
        pg8::Gemm g{(const bf16_t*)(F.ws + WS_H), (const bf16_t*)(F.ws + WS_WD), FH / 2}; pg8::OrdMoe<4> S{F.G, (int)blockIdx.x, 0, 1 << 30}; pg8::EpiDown E{(const float*)(F.ws + WS_GATE), (bf16_t*)(F.ws + WS_YG)};
        pg8::gemm_phase<pg8::EpiDown, pg8::OrdMoe<4>, true, true, false, true>(F.lds, g, S, E);
    } SEAM(9);
    if (IN(10)) { p10_final<false>(F, args); }
    if (IN(11)) { p10_final<true>(F, args); }
#undef IN
#undef SEAM
}

#if MK_ATTN_PROBE >= 0
__global__ void __launch_bounds__(NWAVES * 64, 2) mk_attn_probe(Args args) {
    extern __shared__ __attribute__((aligned(16))) unsigned char lds[];
    Frame F; F.lds = (LAS unsigned char*)lds; F.tid = threadIdx.x; F.lane = F.tid & 63; F.wave = __builtin_amdgcn_readfirstlane(F.tid >> 6);
    F.G = gridDim.x; { const int bx = blockIdx.x; F.vcu = (F.G % 8 == 0) ? (bx % 8) * (F.G / 8) + bx / 8 : bx; } F.ws = args.ws;
    p3_attn<MK_ATTN_PROBE>(F, args, (char*)lds);
}
#endif
extern "C" void kernel_launch(void* const* d_in, const int* in_sizes, int n_in, void* d_out, int out_size, void* d_ws, size_t ws_size, hipStream_t stream) {
    static int grid = 0;
    if (grid == 0) {
        if (n_in != 23 || in_sizes[0] != MX * DM || out_size != MX * DM || ws_size < WS_END) {
            fprintf(stderr, "kernel_launch: unexpected shapes: n_in %d in0 %d out %d ws %zu (need %zu)\n", n_in, n_in > 0 ? in_sizes[0] : -1, out_size, ws_size, (size_t)WS_END); grid = -1; return; }
        int dev = 0, cus = 0;
        if (hipGetDevice(&dev) != hipSuccess || hipDeviceGetAttribute(&cus, hipDeviceAttributeMultiprocessorCount, dev) != hipSuccess) { grid = -1; return; }
        if (hipFuncSetAttribute((const void*)mk_fwd, hipFuncAttributeMaxDynamicSharedMemorySize, LDS_BYTES) != hipSuccess) { fprintf(stderr, "kernel_launch: hipFuncSetAttribute failed\n"); grid = -1; return; }
        int per_cu = 0;
        if (hipOccupancyMaxActiveBlocksPerMultiprocessor(&per_cu, (const void*)mk_fwd, NWAVES * 64, LDS_BYTES) != hipSuccess || per_cu < 1) fprintf(stderr, "kernel_launch: occupancy query reports %d\n", per_cu);
        (void)hipGetLastError();
        grid = cus;
    }
    if (grid < 0) return;
    if (hipMemsetAsync((char*)d_ws + WS_CTL, 0, CTL_ZERO_BYTES, stream) != hipSuccess) return;
    Args a{};
    for (int i = 0; i < 23; ++i) a.in[i] = (const float*)d_in[i];
    a.out = (float*)d_out; a.ws = (unsigned char*)d_ws;
#if MK_ATTN_PROBE >= 0
    (void)hipFuncSetAttribute((const void*)mk_attn_probe, hipFuncAttributeMaxDynamicSharedMemorySize, LDS_BYTES);
    a.ph_lo = 0; a.ph_hi = 4; a.li = 0; hipLaunchKernelGGL(mk_fwd, dim3(grid), dim3(NWAVES * 64), LDS_BYTES, stream, a);
    hipLaunchKernelGGL(mk_attn_probe, dim3(grid), dim3(NWAVES * 64), LDS_BYTES, stream, a);
    a.ph_lo = 4; a.ph_hi = N_PHASES; a.li = 1; hipLaunchKernelGGL(mk_fwd, dim3(grid), dim3(NWAVES * 64), LDS_BYTES, stream, a);
    return;
#endif
#ifdef MK_P10_PROBE
    a.ph_lo = 0; a.ph_hi = 10; a.li = 0; hipLaunchKernelGGL(mk_fwd, dim3(grid), dim3(NWAVES * 64), LDS_BYTES, stream, a);
    a.ph_lo = 11; a.ph_hi = 12; a.li = 1; hipLaunchKernelGGL(mk_fwd, dim3(grid), dim3(NWAVES * 64), LDS_BYTES, stream, a);
    a.ph_lo = 10; a.ph_hi = 11; a.li = 1; hipLaunchKernelGGL(mk_fwd, dim3(grid), dim3(NWAVES * 64), LDS_BYTES, stream, a);
    return;
#endif
    if (MK_PROBE_LO >= 0) {
        a.ph_lo = 0; a.ph_hi = MK_PROBE_HI; a.li = 0; hipLaunchKernelGGL(mk_fwd, dim3(grid), dim3(NWAVES * 64), LDS_BYTES, stream, a);
        a.ph_lo = MK_PROBE_LO; a.ph_hi = N_PHASES; a.li = 1; hipLaunchKernelGGL(mk_fwd, dim3(grid), dim3(NWAVES * 64), LDS_BYTES, stream, a);
        return;
    }
    for (int li = 0; li < N_LAUNCHES; ++li) {
        a.ph_lo = (N_LAUNCHES == 1) ? 0 : li; a.ph_hi = (N_LAUNCHES == 1) ? N_PHASES : li + 1; a.li = (N_LAUNCHES == 1) ? 0 : 0;
        hipLaunchKernelGGL(mk_fwd, dim3(grid), dim3(NWAVES * 64), LDS_BYTES, stream, a);
    }
}
```

```cpp
#include <hip/hip_runtime.h>
#include <cstdio>
#include <cstdint>

#ifndef MK_N_LAUNCHES
#define MK_N_LAUNCHES 1
#endif
#ifndef MK_PROBE_LO
#define MK_PROBE_LO -1
#define MK_PROBE_HI -1
#endif
constexpr int N_PHASES = 11;
constexpr int N_LAUNCHES = MK_N_LAUNCHES;

constexpr int DM = 1024, NB = 8, SEQ = 2048, CTXL = 256;
constexpr int MX = NB * SEQ;
constexpr int MC = NB * CTXL;
constexpr int MA = MX + MC;
constexpr int SKV = CTXL + SEQ;
constexpr int NH = 8;
constexpr int NE = 16, FH = 2048, CAP = 256;
constexpr int MS = NE * NB * CAP;
constexpr int NMOD = 6 * DM;
constexpr float EPS = 1e-6f;
constexpr float LAM_INIT = 0.2f;

constexpr size_t MiB = 1u << 20;
constexpr size_t WS_CTL = 0, CTL_ZERO_BYTES = 64 * 1024;
constexpr size_t WS_MODS = 1 * MiB;
constexpr size_t WS_AFF = 2 * MiB;
constexpr size_t WS_SLOT = 3 * MiB;
constexpr size_t WS_GATE = 4 * MiB;
constexpr size_t WS_GIDX = 5 * MiB;
constexpr size_t WS_WIN = 8 * MiB;
constexpr size_t WS_WC = 24 * MiB, WS_WO = 26 * MiB, WS_WOUT = 28 * MiB;
constexpr size_t WS_Z = 32 * MiB, WS_GB = 64 * MiB, WS_Q = 96 * MiB, WS_KALL = 128 * MiB, WS_VALL = 164 * MiB, WS_S6 = 200 * MiB, WS_S7 = 232 * MiB;
constexpr size_t WS_H = 32 * MiB;
constexpr size_t WS_WGU = 428 * MiB;
constexpr size_t WS_A1 = 264 * MiB;
constexpr size_t WS_HX2 = 288 * MiB;
constexpr size_t WS_YG = 288 * MiB;
constexpr size_t WS_OATT = 300 * MiB;
constexpr size_t WS_MERGED = 332 * MiB;
constexpr size_t WS_O1 = 364 * MiB;
constexpr size_t WS_MIX = 364 * MiB;
constexpr size_t WS_WD = 396 * MiB;
constexpr size_t WS_END = 492 * MiB;

constexpr int RING_BYTES = 131072;
constexpr int ROPE_OFF = RING_BYTES;
constexpr int GTAB_OFF = ROPE_OFF + 8192;
constexpr int LDSCTL_OFF = GTAB_OFF + 8192, MISC_OFF = LDSCTL_OFF + 320;
constexpr int LDS_BYTES = 155648;

#define GAS __attribute__((address_space(1)))
#define LAS __attribute__((address_space(3)))
typedef unsigned short bf16_t;
typedef unsigned v4u __attribute__((ext_vector_type(4)));
typedef unsigned v2u __attribute__((ext_vector_type(2)));
typedef float f32x4 __attribute__((ext_vector_type(4)));
typedef float f32x2 __attribute__((ext_vector_type(2)));
typedef short bf16x8 __attribute__((ext_vector_type(8)));
typedef GAS unsigned gu32;
#define RLX_AGENT __ATOMIC_RELAXED, __HIP_MEMORY_SCOPE_AGENT
#define LDS_WAIT() asm volatile("s_waitcnt lgkmcnt(0)" ::: "memory")
#define VM_WAIT() asm volatile("s_waitcnt vmcnt(0)" ::: "memory")

__device__ __forceinline__ unsigned f2bf(float f) { unsigned u = __builtin_bit_cast(unsigned, f); return (u + 0x7fffu + ((u >> 16) & 1u)) >> 16; }
__device__ __forceinline__ unsigned pk2(float lo, float hi) { return f2bf(lo) | (f2bf(hi) << 16); }
__device__ __forceinline__ float bf_lo(unsigned w) { return __builtin_bit_cast(float, w << 16); }
__device__ __forceinline__ float bf_hi(unsigned w) { return __builtin_bit_cast(float, w & 0xffff0000u); }
__device__ __forceinline__ unsigned cvt_pk_bf16(float lo, float hi) { unsigned r; asm volatile("v_cvt_pk_bf16_f32 %0, %1, %2" : "=v"(r) : "v"(lo), "v"(hi)); return r; }
__device__ __forceinline__ float wave_sum(float v) {
#pragma unroll
    for (int o = 1; o < 64; o <<= 1) v += __shfl_xor(v, o);
    return v;
}
__device__ __forceinline__ float swap32(float v, bool lo_half) {
    auto r = __builtin_amdgcn_permlane32_swap(__builtin_bit_cast(unsigned, v), __builtin_bit_cast(unsigned, v), false, false);
    return __builtin_bit_cast(float, lo_half ? r[1] : r[0]);
}
__device__ __forceinline__ unsigned pk_fp8x4(float a, float b, float c, float d) {
    a = __builtin_amdgcn_fmed3f(a, -448.f, 448.f); b = __builtin_amdgcn_fmed3f(b, -448.f, 448.f); c = __builtin_amdgcn_fmed3f(c, -448.f, 448.f); d = __builtin_amdgcn_fmed3f(d, -448.f, 448.f);
    int w = 0; w = __builtin_amdgcn_cvt_pk_fp8_f32(a, b, w, false); w = __builtin_amdgcn_cvt_pk_fp8_f32(c, d, w, true); return (unsigned)w; }
__device__ __forceinline__ float sigmoidf_(float x) { return __builtin_amdgcn_rcpf(1.f + __builtin_amdgcn_exp2f(-1.4426950408889634f * x)); }

namespace pg8 {
#define PG8_LAS __attribute__((address_space(3)))
typedef float f32x4 __attribute__((ext_vector_type(4)));
typedef unsigned u32x4 __attribute__((ext_vector_type(4)));
typedef int v4i_ __attribute__((ext_vector_type(4)));
typedef int v8i_ __attribute__((ext_vector_type(8)));
constexpr int BM = 256, BK = 64, HALF = 128, HTB = HALF * BK * 2, STAGE_BYTES = 8 * HTB, NXCD = 8, WGM = 8;

__host__ __device__ __forceinline__ int lds_byte(int r, int c) { const int st = (r >> 4) * 2 + (c >> 5), rr = r & 15, cc = c & 31, ob = rr * 64 + cc * 2; return st * 1024 + (ob ^ (((ob >> 9) & 1) << 5)); }
__host__ __device__ __forceinline__ void stage_rc(int b, int& R, int& C) { const int st = b / 1024, sb = b % 1024, swz = sb ^ (((sb >> 9) & 1) << 5); R = (st >> 1) * 16 + swz / 64; C = (st & 1) * 32 + (swz % 64) / 2; }
__host__ __device__ __forceinline__ int perm32(int rho) { const int n = rho >> 4, i = rho & 15; return 8 * (i >> 2) + 4 * n + (i & 3); }

struct Unit { int pm, pb, pn; };
struct Gemm { const bf16_t* A; const bf16_t* Bt; int K; };

struct OrdGrid {
    int nM, nN, nwg, G, c;
    __device__ __forceinline__ void init(int nM_, int nN_, int G_, int c_) { nM = nM_; nN = nN_; nwg = nM * nN; G = G_; c = c_; }
    __device__ __forceinline__ bool next(int i, Unit& u) const {
        const long L = (long)i * G + c; if (L >= nwg) return false;
        int wgid = (int)L; { const int q = nwg / NXCD, xcd = wgid % NXCD, off = wgid / NXCD; wgid = xcd * q + off; }
        const int nig = WGM * nN, gid = wgid / nig, fm = gid * WGM;
        u.pm = fm + ((wgid % nig) % WGM); u.pn = (wgid % nig) / WGM; u.pb = u.pn; return true;
    }
};
struct OrdMerge {
    OrdGrid base; int pmA0, pmA1, pbB0, pbB1;
    __device__ __forceinline__ bool next(int i, Unit& u) const {
        Unit t; if (!base.next(i >> 1, t)) return false;
        const int ty = i & 1; u.pm = (ty ? pmA1 : pmA0) + t.pm; u.pb = (ty ? pbB1 : pbB0) + t.pn; u.pn = ty * 4 + t.pn + 8 * t.pm; return true;
    }
};
struct OrdInProj {
    int G, c;
    __device__ __forceinline__ bool next(int i, Unit& u) const {
        const long L = (long)i * G + c; if (L >= 2048 + 64) return false;
        if (L < 2048) { const int wgid = (int)(L % 8) * 256 + (int)(L / 8); const int w = wgid % 256; u.pm = (wgid / 256) * 8 + (w % 8); u.pn = w / 8; }
        else { const int l2 = (int)L - 2048; u.pm = 64 + (l2 & 7); u.pn = 16 + (l2 >> 3); }
        u.pb = u.pn; return true;
    }
};
template <int NT> struct OrdMoe {
    int G, c, i0, imax;
    __device__ __forceinline__ bool next(int i, Unit& u) const {
        constexpr int nwg = 128 * NT;
        if (i >= imax) return false;
        const long L = (long)(i0 + i) * G + c; if (L >= nwg) return false;
        const int wgid = (int)(L % 8) * (nwg / 8) + (int)(L / 8);
        const int e = wgid / (8 * NT), w = wgid % (8 * NT);
        u.pm = e * 8 + (w % 8); u.pn = w / 8; u.pb = e * NT + u.pn; return true;
    }
};

template <class Epi, class Sched, bool ALIGN_EPI = false, bool SP2 = false, bool GATHER = false, bool FP8 = false>
__device__ __forceinline__ void gemm_phase(PG8_LAS unsigned char* lds, const Gemm g, const Sched& S, const Epi& E, const PG8_LAS unsigned* gtab = nullptr) {
    const int tid = threadIdx.x, wid = __builtin_amdgcn_readfirstlane(tid >> 6), lane = tid & 63, wr = wid >> 2, wc = wid & 3, fr = lane & 15, fq = lane >> 4;
    const int K = g.K, nt = K / BK;
    unsigned voffA[2], voffB[2];
#pragma unroll
    for (int i = 0; i < 2; ++i) { int R, C; stage_rc(tid * 16 + i * 8192, R, C); const int Rb = ((R & ~31) + perm32(R & 31));
        voffA[i] = (unsigned)(R * K + C) * 2u; voffB[i] = (unsigned)(Rb * K + C) * 2u; }
    const size_t kstep = (size_t)(BK * 2);
    const size_t hstep = (size_t)HALF * K * 2;
    const size_t tstep = 2 * hstep;
    const unsigned ldsw = (unsigned)wid * 1024u;
    int gR[2], gC2[2];
#pragma unroll
    for (int i = 0; i < 2; ++i) { int R, C; stage_rc(tid * 16 + i * 8192, R, C); gR[i] = R; gC2[i] = C * 2; }
    unsigned cO0[2], cO1[2], nO0[2], nO1[2];
#define PG8_GOFF(O0, O1, ui_) do { _Pragma("unroll") for (int _i = 0; _i < 2; ++_i) { O0[_i] = gtab[((ui_) & 7) * 256 + gR[_i]] + gC2[_i]; O1[_i] = gtab[((ui_) & 7) * 256 + 128 + gR[_i]] + gC2[_i]; } } while (0)
    const int aoff = lds_byte(wr * 64 + fr, fq * 8), boff = lds_byte(wc * 32 + fr, fq * 8);
#define PG8_SA(b, h) (((b) * 2 + (h)) * HTB)
#define PG8_SB(b, h) ((4 + (b) * 2 + (h)) * HTB)
#define PG8_STAGE(bufoff, gbase, voff) do { _Pragma("unroll") for (int _i = 0; _i < 2; ++_i) \
        __builtin_amdgcn_global_load_lds((const unsigned*)((const char*)(gbase) + (voff)[_i]), (PG8_LAS unsigned*)(lds + (bufoff) + ldsw + _i * 8192), 16, 0, 0); } while (0)
#define PG8_LD8(p) __builtin_shufflevector(*(const PG8_LAS v4i_*)(p), *(const PG8_LAS v4i_*)((p) + 1024), 0, 1, 2, 3, 4, 5, 6, 7)
#define PG8_LDA(dst, b, h) do { if constexpr (FP8) { _Pragma("unroll") for (int m = 0; m < 4; ++m) dst##8[m] = PG8_LD8(lds + PG8_SA(b, h) + aoff + m * 2048); } \
        else { _Pragma("unroll") for (int m = 0; m < 4; ++m) _Pragma("unroll") for (int k = 0; k < 2; ++k) dst[m][k] = *(const PG8_LAS bf16x8*)(lds + PG8_SA(b, h) + aoff + m * 2048 + k * 1024); } } while (0)
#define PG8_LDB(dst, b, h) do { if constexpr (FP8) { _Pragma("unroll") for (int n = 0; n < 2; ++n) dst##8[n] = PG8_LD8(lds + PG8_SB(b, h) + boff + n * 2048); } \
        else { _Pragma("unroll") for (int n = 0; n < 2; ++n) _Pragma("unroll") for (int k = 0; k < 2; ++k) dst[n][k] = *(const PG8_LAS bf16x8*)(lds + PG8_SB(b, h) + boff + n * 2048 + k * 1024); } } while (0)
#define PG8_MMA(ai, bj, At, Bt) do { __builtin_amdgcn_s_setprio(1); _Pragma("unroll") for (int m = 0; m < 4; ++m) _Pragma("unroll") for (int n = 0; n < 2; ++n) { \
        if constexpr (FP8) asm("v_mfma_scale_f32_16x16x128_f8f6f4 %0, %1, %2, %0, %3, %4 op_sel_hi:[0,0,0]" : "+v"(acc[ai][bj][m][n]) : "v"(Bt##8[n]), "v"(At##8[m]), "v"(scw8), "v"(sca8)); \
        else { _Pragma("unroll") for (int k = 0; k < 2; ++k) acc[ai][bj][m][n] = __builtin_amdgcn_mfma_f32_16x16x32_bf16(Bt[n][k], At[m][k], acc[ai][bj][m][n], 0, 0, 0); } } __builtin_amdgcn_s_setprio(0); } while (0)
#define PG8_WAIT_V(n) asm volatile("s_waitcnt vmcnt(" #n ")" ::: "memory")
#define PG8_WAIT_L(n) asm volatile("s_waitcnt lgkmcnt(" #n ")" ::: "memory")
#define PG8_BAR __builtin_amdgcn_s_barrier()
#define PG8_SCHED __builtin_amdgcn_sched_barrier(0)
    Unit cur, nxt; int ui = 0;
    if (!S.next(0, cur)) return;
    f32x4 acc[2][2][4][2];
#pragma unroll
    for (int a = 0; a < 2; ++a)
#pragma unroll
        for (int b = 0; b < 2; ++b)
#pragma unroll
            for (int m = 0; m < 4; ++m)
#pragma unroll
                for (int n = 0; n < 2; ++n) acc[a][b][m][n] = (f32x4){0.f, 0.f, 0.f, 0.f};
    int scw8 = 0x7b7b7b7b, sca8 = 0x7f7f7f7f; asm volatile("" : "+v"(scw8), "+v"(sca8));
    bf16x8 At[4][2], B0[2][2], B1[2][2]; v8i_ At8[4], B08[2], B18[2];
    const char* cA = GATHER ? (const char*)g.A : (const char*)g.A + (size_t)cur.pm * tstep; const char* cB = (const char*)g.Bt + (size_t)cur.pb * tstep;
    if constexpr (GATHER) { PG8_GOFF(cO0, cO1, 0); }
    if constexpr (SP2 && GATHER) {
        PG8_STAGE(PG8_SB(0, 0), cB, voffB); PG8_STAGE(PG8_SB(0, 1), cB + hstep, voffB); PG8_STAGE(PG8_SA(0, 0), cA, cO0); PG8_STAGE(PG8_SA(0, 1), cA, cO1);
        if (wr == 1) PG8_BAR;
        PG8_WAIT_V(2); PG8_BAR;
        PG8_STAGE(PG8_SB(1, 0), cB + kstep, voffB); PG8_STAGE(PG8_SA(1, 0), cA + kstep, cO0); PG8_STAGE(PG8_SB(1, 1), cB + hstep + kstep, voffB);
        PG8_WAIT_V(6); PG8_BAR;
    } else if constexpr (SP2) {
        PG8_STAGE(PG8_SB(0, 0), cB, voffB); PG8_STAGE(PG8_SB(0, 1), cB + hstep, voffB); PG8_STAGE(PG8_SA(0, 0), cA, voffA); PG8_STAGE(PG8_SA(0, 1), cA + hstep, voffA);
        if (wr == 1) PG8_BAR;
        PG8_WAIT_V(2); PG8_BAR;
        PG8_STAGE(PG8_SB(1, 0), cB + kstep, voffB); PG8_STAGE(PG8_SA(1, 0), cA + kstep, voffA); PG8_STAGE(PG8_SB(1, 1), cB + hstep + kstep, voffB);
        PG8_WAIT_V(6); PG8_BAR;
    } else {
        PG8_STAGE(PG8_SB(0, 0), cB, voffB); PG8_STAGE(PG8_SA(0, 0), cA, voffA); PG8_STAGE(PG8_SB(0, 1), cB + hstep, voffB); PG8_STAGE(PG8_SA(0, 1), cA + hstep, voffA);
        if (wr == 1) PG8_BAR;
        PG8_WAIT_V(4); PG8_BAR;
        PG8_STAGE(PG8_SB(1, 0), cB + kstep, voffB); PG8_STAGE(PG8_SA(1, 0), cA + kstep, voffA); PG8_STAGE(PG8_SB(1, 1), cB + hstep + kstep, voffB);
        PG8_WAIT_V(6); PG8_BAR;
    }
    for (;;) {
        const bool has_next = S.next(ui + 1, nxt);
        const char* nA = GATHER ? cA : (has_next ? (const char*)g.A + (size_t)nxt.pm * tstep : cA); const char* nB = has_next ? (const char*)g.Bt + (size_t)nxt.pb * tstep : cB;
        if constexpr (GATHER) { if (has_next) { PG8_GOFF(nO0, nO1, ui + 1); } else {
#pragma unroll
            for (int _i = 0; _i < 2; ++_i) { nO0[_i] = cO0[_i]; nO1[_i] = cO1[_i]; } } }
        for (int t = 0; t < nt; t += 2) {
            const bool last = (t == nt - 2);
            const char* a1 = cA + (size_t)(t + 1) * kstep;
            const char* a2 = last ? nA : cA + (size_t)(t + 2) * kstep; const char* b2 = last ? nB : cB + (size_t)(t + 2) * kstep;
            const char* a3 = a2 + kstep; const char* b3 = b2 + kstep;
            if constexpr (SP2 && GATHER) {
            unsigned s0[2], s1[2];
#pragma unroll
            for (int _i = 0; _i < 2; ++_i) { s0[_i] = last ? nO0[_i] : cO0[_i]; s1[_i] = last ? nO1[_i] : cO1[_i]; }
            const char* g2 = last ? cA : cA + (size_t)(t + 2) * kstep; const char* g3 = g2 + kstep;
            PG8_LDB(B0, 0, 0); PG8_LDB(B1, 0, 1); PG8_SCHED; PG8_LDA(At, 0, 0); PG8_STAGE(PG8_SA(1, 1), a1, cO1);
            PG8_WAIT_V(8); PG8_WAIT_L(0); PG8_BAR; PG8_MMA(0, 0, At, B0); PG8_MMA(0, 1, At, B1); PG8_BAR; PG8_SCHED;
            PG8_LDA(At, 0, 1); PG8_STAGE(PG8_SB(0, 0), b2, voffB); PG8_STAGE(PG8_SB(0, 1), b2 + hstep, voffB); PG8_STAGE(PG8_SA(0, 0), g2, s0);
            PG8_WAIT_V(8); PG8_WAIT_L(0); PG8_BAR; PG8_MMA(1, 0, At, B0); PG8_MMA(1, 1, At, B1); PG8_BAR; PG8_SCHED;
            PG8_LDB(B0, 1, 0); PG8_LDB(B1, 1, 1); PG8_SCHED; PG8_LDA(At, 1, 0); PG8_STAGE(PG8_SA(0, 1), g2, s1);
            PG8_WAIT_V(8); PG8_WAIT_L(0); PG8_BAR; PG8_MMA(0, 0, At, B0); PG8_MMA(0, 1, At, B1); PG8_BAR; PG8_SCHED;
            PG8_LDA(At, 1, 1); PG8_STAGE(PG8_SB(1, 0), b3, voffB); PG8_STAGE(PG8_SB(1, 1), b3 + hstep, voffB); PG8_STAGE(PG8_SA(1, 0), g3, s0);
            PG8_WAIT_V(8); PG8_WAIT_L(0); PG8_BAR; PG8_MMA(1, 0, At, B0); PG8_MMA(1, 1, At, B1); PG8_BAR; PG8_SCHED;
            } else if constexpr (SP2) {
            PG8_LDB(B0, 0, 0); PG8_LDB(B1, 0, 1); PG8_SCHED; PG8_LDA(At, 0, 0); PG8_STAGE(PG8_SA(1, 1), a1 + hstep, voffA);
            PG8_WAIT_V(8); PG8_WAIT_L(0); PG8_BAR; PG8_MMA(0, 0, At, B0); PG8_MMA(0, 1, At, B1); PG8_BAR; PG8_SCHED;
            PG8_LDA(At, 0, 1); PG8_STAGE(PG8_SB(0, 0), b2, voffB); PG8_STAGE(PG8_SB(0, 1), b2 + hstep, voffB); PG8_STAGE(PG8_SA(0, 0), a2, voffA);
            PG8_WAIT_V(8); PG8_WAIT_L(0); PG8_BAR; PG8_MMA(1, 0, At, B0); PG8_MMA(1, 1, At, B1); PG8_BAR; PG8_SCHED;
            PG8_LDB(B0, 1, 0); PG8_LDB(B1, 1, 1); PG8_SCHED; PG8_LDA(At, 1, 0); PG8_STAGE(PG8_SA(0, 1), a2 + hstep, voffA);
            PG8_WAIT_V(8); PG8_WAIT_L(0); PG8_BAR; PG8_MMA(0, 0, At, B0); PG8_MMA(0, 1, At, B1); PG8_BAR; PG8_SCHED;
            PG8_LDA(At, 1, 1); PG8_STAGE(PG8_SB(1, 0), b3, voffB); PG8_STAGE(PG8_SB(1, 1), b3 + hstep, voffB); PG8_STAGE(PG8_SA(1, 0), a3, voffA);
            PG8_WAIT_V(8); PG8_WAIT_L(0); PG8_BAR; PG8_MMA(1, 0, At, B0); PG8_MMA(1, 1, At, B1); PG8_BAR; PG8_SCHED;
            } else {
            PG8_LDB(B0, 0, 0); PG8_SCHED; PG8_LDA(At, 0, 0); PG8_STAGE(PG8_SA(1, 1), a1 + hstep, voffA);
            PG8_WAIT_L(8); PG8_BAR; PG8_WAIT_L(0); PG8_MMA(0, 0, At, B0); PG8_BAR; PG8_SCHED;
            PG8_LDB(B1, 0, 1); PG8_STAGE(PG8_SB(0, 0), b2, voffB);
            PG8_BAR; PG8_WAIT_L(0); PG8_MMA(0, 1, At, B1); PG8_BAR;
            PG8_LDA(At, 0, 1); PG8_STAGE(PG8_SA(0, 0), a2, voffA);
            PG8_BAR; PG8_WAIT_L(0); PG8_MMA(1, 0, At, B0); PG8_BAR; PG8_SCHED;
            PG8_STAGE(PG8_SB(0, 1), b2 + hstep, voffB);
            PG8_WAIT_V(6); PG8_BAR; PG8_MMA(1, 1, At, B1); PG8_BAR;
            PG8_LDB(B0, 1, 0); PG8_SCHED; PG8_LDA(At, 1, 0); PG8_STAGE(PG8_SA(0, 1), a2 + hstep, voffA);
            PG8_WAIT_L(8); PG8_BAR; PG8_WAIT_L(0); PG8_MMA(0, 0, At, B0); PG8_BAR; PG8_SCHED;
            PG8_LDB(B1, 1, 1); PG8_STAGE(PG8_SB(1, 0), b3, voffB);
            PG8_BAR; PG8_WAIT_L(0); PG8_MMA(0, 1, At, B1); PG8_BAR;
            PG8_LDA(At, 1, 1); PG8_STAGE(PG8_SA(1, 0), a3, voffA);
            PG8_BAR; PG8_WAIT_L(0); PG8_MMA(1, 0, At, B0); PG8_BAR; PG8_SCHED;
            PG8_STAGE(PG8_SB(1, 1), b3 + hstep, voffB);
            PG8_WAIT_V(6); PG8_BAR; PG8_MMA(1, 1, At, B1); PG8_BAR;
            }
        }
        if constexpr (ALIGN_EPI) { if (wr == 0) PG8_BAR; }
        if constexpr (FP8) asm volatile("s_nop 15\n\ts_nop 15" ::: "memory");
        E(acc, cur, wr, wc, fr, fq);
        if (!has_next) break;
        if (!Epi::keep_acc(cur)) {
#pragma unroll
        for (int a = 0; a < 2; ++a)
#pragma unroll
            for (int b = 0; b < 2; ++b)
#pragma unroll
                for (int m = 0; m < 4; ++m)
#pragma unroll
                    for (int n = 0; n < 2; ++n) acc[a][b][m][n] = (f32x4){0.f, 0.f, 0.f, 0.f}; }
        if constexpr (FP8) asm volatile("s_nop 4" ::: "memory");
        cur = nxt; cA = nA; cB = nB; ++ui;
        if constexpr (GATHER) {
#pragma unroll
            for (int _i = 0; _i < 2; ++_i) { cO0[_i] = nO0[_i]; cO1[_i] = nO1[_i]; } }
        if constexpr (ALIGN_EPI) { if (wr == 1) PG8_BAR; }
    }
    PG8_WAIT_V(0);
    if constexpr (!ALIGN_EPI) { if (wr == 0) PG8_BAR; }
    PG8_BAR;
#undef PG8_GOFF
#undef PG8_SA
#undef PG8_SB
#undef PG8_STAGE
#undef PG8_LDA
#undef PG8_LDB
#undef PG8_MMA
#undef PG8_LD8
#undef PG8_WAIT_V
#undef PG8_WAIT_L
#undef PG8_BAR
#undef PG8_SCHED
}

typedef f32x4 Acc[2][2][4][2];
__device__ __forceinline__ v4u pack8(f32x4 v0, f32x4 v1) { v4u w; w.x = cvt_pk_bf16(v0[0], v0[1]); w.y = cvt_pk_bf16(v0[2], v0[3]); w.z = cvt_pk_bf16(v1[0], v1[1]); w.w = cvt_pk_bf16(v1[2], v1[3]); return w; }
__device__ __forceinline__ void unpack8(v4u w, f32x4& v0, f32x4& v1) { v0 = (f32x4){bf_lo(w.x), bf_hi(w.x), bf_lo(w.y), bf_hi(w.y)}; v1 = (f32x4){bf_lo(w.z), bf_hi(w.z), bf_lo(w.w), bf_hi(w.w)}; }

struct EpiInProj {
    bf16_t *Z, *GB, *Q, *KALL, *VALL, *S6, *S7; const LAS float* rope;
    static __device__ __forceinline__ bool keep_acc(const Unit&) { return false; }
    __device__ __forceinline__ void operator()(Acc& acc, const Unit& u, int wr, int wc, int fr, int fq) const {
        const int pn = u.pn, row0 = u.pm * BM + wr * 64 + fr, cw = wc * 32 + 8 * fq;
        if (pn < 8) {
#pragma unroll
            for (int ai = 0; ai < 2; ++ai)
#pragma unroll
                for (int m = 0; m < 4; ++m) { const int row = row0 + ai * HALF + m * 16;
                    *(v4u*)(Z + (size_t)row * DM + pn * 128 + cw) = pack8(acc[ai][0][m][0] * acc[ai][1][m][0], acc[ai][0][m][1] * acc[ai][1][m][1]); }
        } else if (pn < 12) {
#pragma unroll
            for (int ai = 0; ai < 2; ++ai)
#pragma unroll
                for (int m = 0; m < 4; ++m) { const int row = row0 + ai * HALF + m * 16;
#pragma unroll
                    for (int bj = 0; bj < 2; ++bj) *(v4u*)(GB + (size_t)row * DM + (pn - 8) * 256 + bj * HALF + cw) = pack8(acc[ai][bj][m][0], acc[ai][bj][m][1]); }
        } else if (pn < 20) {
            const bool isK = pn >= 16, ctx = u.pm >= 64; const int colb = (pn - (isK ? 16 : 12)) * 256 + cw;
            const bool lo_half = fq < 2; const float sgn = lo_half ? -1.f : 1.f; const int axis = wc & 1, fsel = (fq & 1) * 8;
#pragma unroll
            for (int ai = 0; ai < 2; ++ai)
#pragma unroll
                for (int m = 0; m < 4; ++m) { const int row = row0 + ai * HALF + m * 16;
                    size_t orow; f32x4 cs[4] = {};
                    if (ctx) { const int rc = row - MX; orow = (size_t)(rc >> 8) * SKV + (rc & 255); }
                    else { const int t = row & (SEQ - 1), pos = axis ? (t & 63) : (t >> 6); orow = isK ? (size_t)(row >> 11) * SKV + CTXL + t : (size_t)row;
                        const LAS f32x4* tb = (const LAS f32x4*)(rope + (pos * 16 + fsel) * 2);
#pragma unroll
                        for (int i = 0; i < 4; ++i) cs[i] = tb[i]; }
                    bf16_t* dst = (isK ? KALL : Q) + orow * DM + colb;
#pragma unroll
                    for (int bj = 0; bj < 2; ++bj)
#pragma unroll
                        for (int n = 0; n < 2; ++n) { f32x4 o;
#pragma unroll
                            for (int j = 0; j < 4; ++j) { const float own = acc[ai][bj][m][n][j];
                                if (ctx) o[j] = own;
                                else { const float par = swap32(own, lo_half); const int f = 4 * n + j; const float c = cs[f >> 1][(f & 1) * 2], s = cs[f >> 1][(f & 1) * 2 + 1]; o[j] = own * c + par * (sgn * s); } }
                            v2u w; w.x = cvt_pk_bf16(o[0], o[1]); w.y = cvt_pk_bf16(o[2], o[3]); *(v2u*)(dst + bj * HALF + 4 * n) = w; }
                    asm volatile("" ::: "memory"); }
        } else if (pn < 24) {
            const bool ctx = u.pm >= 64;
#pragma unroll
            for (int ai = 0; ai < 2; ++ai)
#pragma unroll
                for (int m = 0; m < 4; ++m) { const int row = row0 + ai * HALF + m * 16;
                    size_t orow; if (ctx) { const int rc = row - MX; orow = (size_t)(rc >> 8) * SKV + (rc & 255); } else orow = (size_t)(row >> 11) * SKV + CTXL + (row & (SEQ - 1));
#pragma unroll
                    for (int bj = 0; bj < 2; ++bj) *(v4u*)(VALL + orow * DM + (pn - 20) * 256 + bj * HALF + cw) = pack8(acc[ai][bj][m][0], acc[ai][bj][m][1]); }
        } else {
            bf16_t* dstb = pn < 28 ? S6 : S7; const int colb = (pn - (pn < 28 ? 24 : 28)) * 256 + cw;
#pragma unroll
            for (int ai = 0; ai < 2; ++ai)
#pragma unroll
                for (int m = 0; m < 4; ++m) { const int row = row0 + ai * HALF + m * 16;
#pragma unroll
                    for (int bj = 0; bj < 2; ++bj) { f32x4 a = acc[ai][bj][m][0], b = acc[ai][bj][m][1];
#pragma unroll
                        for (int j = 0; j < 4; ++j) { a[j] = sigmoidf_(a[j]); b[j] = sigmoidf_(b[j]); }
                        *(v4u*)(dstb + (size_t)row * DM + colb + bj * HALF) = pack8(a, b); } }
        }
    }
};
struct EpiT1 {
    const bf16_t* S6; float* T;
    static __device__ __forceinline__ bool keep_acc(const Unit&) { return false; }
    __device__ __forceinline__ void operator()(Acc& acc, const Unit& u, int wr, int wc, int fr, int fq) const {
        const int row0 = u.pm * BM + wr * 64 + fr, col0 = u.pn * BM + wc * 32 + 8 * fq;
#pragma unroll
        for (int ai = 0; ai < 2; ++ai)
#pragma unroll
            for (int m = 0; m < 4; ++m) { const size_t off = (size_t)(row0 + ai * HALF + m * 16) * DM + col0;
#pragma unroll
                for (int bj = 0; bj < 2; ++bj) { f32x4 g0, g1; unpack8(*(const v4u*)(S6 + off + bj * HALF), g0, g1);
                    *(f32x4*)(T + off + bj * HALF) = g0 * acc[ai][bj][m][0]; *(f32x4*)(T + off + bj * HALF + 4) = g1 * acc[ai][bj][m][1]; } }
    }
};
struct EpiT2 {
    const bf16_t* S7; const float* T; bf16_t* MG;
    static __device__ __forceinline__ bool keep_acc(const Unit&) { return false; }
    __device__ __forceinline__ void operator()(Acc& acc, const Unit& u, int wr, int wc, int fr, int fq) const {
        const int row0 = u.pm * BM + wr * 64 + fr, col0 = u.pn * BM + wc * 32 + 8 * fq;
#pragma unroll
        for (int ai = 0; ai < 2; ++ai)
#pragma unroll
            for (int m = 0; m < 4; ++m) { const size_t off = (size_t)(row0 + ai * HALF + m * 16) * DM + col0;
#pragma unroll
                for (int bj = 0; bj < 2; ++bj) { f32x4 g0, g1; unpack8(*(const v4u*)(S7 + off + bj * HALF), g0, g1);
                    const f32x4 t0 = *(const f32x4*)(T + off + bj * HALF), t1 = *(const f32x4*)(T + off + bj * HALF + 4);
                    *(v4u*)(MG + off + bj * HALF) = pack8(t0 + g0 * acc[ai][bj][m][0], t1 + g1 * acc[ai][bj][m][1]); } }
    }
};
struct EpiMerge {
    const bf16_t* S6; const bf16_t* S7; bf16_t* MG;
    static __device__ __forceinline__ bool keep_acc(const Unit& u) { return ((u.pn >> 2) & 1) == 0; }
    __device__ __forceinline__ void operator()(Acc& acc, const Unit& u, int wr, int wc, int fr, int fq) const {
        const int ty = (u.pn >> 2) & 1, pnc = u.pn & 3, pmr = u.pn >> 3;
        const int row0 = pmr * BM + wr * 64 + fr, col0 = pnc * BM + wc * 32 + 8 * fq;
        if (ty == 0) {
#pragma unroll
            for (int ai = 0; ai < 2; ++ai)
#pragma unroll
                for (int m = 0; m < 4; ++m) { const size_t off = (size_t)(row0 + ai * HALF + m * 16) * DM + col0;
#pragma unroll
                    for (int bj = 0; bj < 2; ++bj) { f32x4 g0, g1, h0, h1; unpack8(*(const v4u*)(S6 + off + bj * HALF), g0, g1); unpack8(*(const v4u*)(S7 + off + bj * HALF), h0, h1);
#pragma unroll
                        for (int j = 0; j < 4; ++j) { acc[ai][bj][m][0][j] *= g0[j] * __builtin_amdgcn_rcpf(h0[j]); acc[ai][bj][m][1][j] *= g1[j] * __builtin_amdgcn_rcpf(h1[j]); } } }
        } else {
#pragma unroll
            for (int ai = 0; ai < 2; ++ai)
#pragma unroll
                for (int m = 0; m < 4; ++m) { const size_t off = (size_t)(row0 + ai * HALF + m * 16) * DM + col0;
#pragma unroll
                    for (int bj = 0; bj < 2; ++bj) { f32x4 h0, h1; unpack8(*(const v4u*)(S7 + off + bj * HALF), h0, h1);
                        *(v4u*)(MG + off + bj * HALF) = pack8(h0 * acc[ai][bj][m][0], h1 * acc[ai][bj][m][1]); } }
        }
    }
};
struct EpiOut {
    const float* mods; bf16_t* MIX;
    static __device__ __forceinline__ bool keep_acc(const Unit&) { return false; }
    __device__ __forceinline__ void operator()(Acc& acc, const Unit& u, int wr, int wc, int fr, int fq) const {
        const int row0 = u.pm * BM + wr * 64 + fr, col0 = u.pn * BM + wc * 32 + 8 * fq, b = (u.pm * BM) >> 11;
        f32x4 g[2][2];
#pragma unroll
        for (int bj = 0; bj < 2; ++bj)
#pragma unroll
            for (int n = 0; n < 2; ++n) g[bj][n] = *(const f32x4*)(mods + (size_t)b * NMOD + 2 * DM + col0 + bj * HALF + 4 * n);
#pragma unroll
        for (int ai = 0; ai < 2; ++ai)
#pragma unroll
            for (int m = 0; m < 4; ++m) { const size_t off = (size_t)(row0 + ai * HALF + m * 16) * DM + col0;
#pragma unroll
                for (int bj = 0; bj < 2; ++bj) *(v4u*)(MIX + off + bj * HALF) = pack8(g[bj][0] * acc[ai][bj][m][0], g[bj][1] * acc[ai][bj][m][1]); }
    }
};
struct EpiSwiGLU {
    unsigned char* H;
    static __device__ __forceinline__ bool keep_acc(const Unit&) { return false; }
    __device__ __forceinline__ void operator()(Acc& acc, const Unit& u, int wr, int wc, int fr, int fq) const {
        const int row0 = u.pm * BM + wr * 64 + fr, col0 = u.pn * 128 + wc * 32 + 8 * fq;
#pragma unroll
        for (int ai = 0; ai < 2; ++ai)
#pragma unroll
            for (int m = 0; m < 4; ++m) { f32x4 o[2];
#pragma unroll
                for (int n = 0; n < 2; ++n)
#pragma unroll
                    for (int j = 0; j < 4; ++j) { const float g = acc[ai][0][m][n][j]; o[n][j] = (g * acc[ai][1][m][n][j]) * __builtin_amdgcn_rcpf(1.f + __builtin_amdgcn_exp2f(g)); }
                v2u w; w.x = pk_fp8x4(o[0][0], o[0][1], o[0][2], o[0][3]); w.y = pk_fp8x4(o[1][0], o[1][1], o[1][2], o[1][3]);
                *(v2u*)(H + (size_t)(row0 + ai * HALF + m * 16) * FH + col0) = w; }
    }
};
struct EpiDown {
    const float* gate; bf16_t* YG;
    static __device__ __forceinline__ bool keep_acc(const Unit&) { return false; }
    __device__ __forceinline__ void operator()(Acc& acc, const Unit& u, int wr, int wc, int fr, int fq) const {
        const int row0 = u.pm * BM + wr * 64 + fr, col0 = u.pn * BM + wc * 32 + 8 * fq;
#pragma unroll
        for (int ai = 0; ai < 2; ++ai)
#pragma unroll
            for (int m = 0; m < 4; ++m) { const int row = row0 + ai * HALF + m * 16; const float gt = gate[row];
#pragma unroll
                for (int bj = 0; bj < 2; ++bj) *(v4u*)(YG + (size_t)row * DM + col0 + bj * HALF) = pack8(acc[ai][bj][m][0] * gt, acc[ai][bj][m][1] * gt); }
    }
};
}

namespace att {
using s16x4 = __attribute__((ext_vector_type(4))) short;
using f32x16 = __attribute__((ext_vector_type(16))) float;
using u32x4 = __attribute__((ext_vector_type(4))) unsigned;
constexpr int NW = 8, QBLK = 32, KVBLK = 64, LD = 1024;
constexpr float SCALE = 0.125f;
constexpr float THR = 8.f;
constexpr size_t SHM_V = KVBLK * 128 * 2, SHM_K = KVBLK * 64 * 2, NSLOT = 3, SHM_ATTN = NSLOT * (SHM_V + SHM_K) + NW * 64 * 4;
#define KSWZ(row, chunk) ((row) * 128 + ((((chunk) ^ ((row) >> 1)) & 7) << 4))
#define SBAR() __builtin_amdgcn_sched_barrier(0)
#ifndef MK_ATTN_PROBE
#define MK_ATTN_PROBE -1
#endif
#define AV_NOSM(V) ((V) == 5 || (V) == 6 || (V) == 7 || (V) == 8 || (V) == 9 || (V) == 10)
#define AV_NOSTAGE(V) ((V) == 9 || (V) == 10)
#define AV_NOPV(V) ((V) == 2 || (V) == 6)
#define AV_NOQK(V) ((V) == 4 || (V) == 7)
#define AV_NOSYNC(V) ((V) == 3 || (V) == 8 || (V) == 10)
__device__ __forceinline__ int crow(int r, int hi) { return (r & 3) + 8 * (r >> 2) + 4 * hi; }
__device__ __forceinline__ unsigned cvtpk(float lo, float hi) { unsigned r; asm volatile("v_cvt_pk_bf16_f32 %0, %1, %2" : "=v"(r) : "v"(lo), "v"(hi)); return r; }

__device__ __forceinline__ void partialSM(f32x16& p0, f32x16& p1, float& m_reg, float& mn, float& alpha) {
  constexpr float C = SCALE * 1.4426950408889634f;
  float pmax = p0[0];
#pragma unroll
  for (int r = 1; r < 16; ++r) pmax = fmaxf(pmax, p0[r]);
#pragma unroll
  for (int r = 0; r < 16; ++r) pmax = fmaxf(pmax, p1[r]);
  { auto rr = __builtin_amdgcn_permlane32_swap(__float_as_uint(pmax), __float_as_uint(pmax), false, false);
    pmax = fmaxf(__uint_as_float(rr[0]), __uint_as_float(rr[1])); }
  if (__builtin_expect(__all(pmax - m_reg <= THR / SCALE), 1)) { mn = m_reg; alpha = 1.f; }
  else { mn = fmaxf(m_reg, pmax); alpha = __builtin_amdgcn_exp2f((m_reg - mn) * C); m_reg = mn; }
  float mnC = -mn * C;
#pragma unroll
  for (int r = 0; r < 16; ++r) p0[r] = fmaf(p0[r], C, mnC);
#pragma unroll
  for (int r = 0; r < 16; ++r) p1[r] = fmaf(p1[r], C, mnC);
#pragma unroll
  for (int r = 0; r < 16; ++r) p0[r] = __builtin_amdgcn_exp2f(p0[r]);
#pragma unroll
  for (int r = 0; r < 16; ++r) p1[r] = __builtin_amdgcn_exp2f(p1[r]);
}
template <int VAR> __device__ __forceinline__ void finishSM(f32x16& p0, f32x16& p1, float alpha, float& l_reg, bf16x8& pa0, bf16x8& pa1, bf16x8& pa2, bf16x8& pa3) {
  if constexpr (AV_NOSM(VAR)) { asm volatile("" : "+v"(p0), "+v"(p1)); pa0 = pa1 = pa2 = pa3 = *reinterpret_cast<bf16x8*>(&p0); return; }
  float ps = 0;
#pragma unroll
  for (int r = 0; r < 16; ++r) ps += p0[r];
#pragma unroll
  for (int r = 0; r < 16; ++r) ps += p1[r];
  { auto rr = __builtin_amdgcn_permlane32_swap(__float_as_uint(ps), __float_as_uint(ps), false, false);
    ps = __uint_as_float(rr[0]) + __uint_as_float(rr[1]); }
  l_reg = l_reg * alpha + ps;
#define PK4(P, BASE, OUT) do { unsigned a0 = cvtpk(P[BASE + 0], P[BASE + 1]), a1 = cvtpk(P[BASE + 2], P[BASE + 3]);   \
    unsigned b0 = cvtpk(P[BASE + 4], P[BASE + 5]), b1 = cvtpk(P[BASE + 6], P[BASE + 7]);                              \
    auto r0 = __builtin_amdgcn_permlane32_swap(a0, b0, false, false); auto r1 = __builtin_amdgcn_permlane32_swap(a1, b1, false, false); \
    u32x4 w = {r0[0], r1[0], r0[1], r1[1]}; OUT = *reinterpret_cast<bf16x8*>(&w); } while (0)
  PK4(p0, 0, pa0); PK4(p0, 8, pa1); PK4(p1, 0, pa2); PK4(p1, 8, pa3);
#undef PK4
}
template <int VAR> __device__ __forceinline__ void qkt(f32x16& p0, f32x16& p1, const char* Ks, const bf16x8* qr, int r32, int hi) {
  p0 = f32x16{}; p1 = f32x16{};
  if constexpr (AV_NOQK(VAR)) { asm volatile("" : "+v"(p0), "+v"(p1)); return; }
#pragma unroll
  for (int d0 = 0; d0 < 4; ++d0) { const int ch = d0 * 2 + hi;
    bf16x8 b0 = *reinterpret_cast<const bf16x8*>(Ks + KSWZ(r32, ch));
    bf16x8 b1 = *reinterpret_cast<const bf16x8*>(Ks + KSWZ(32 + r32, ch));
    p0 = __builtin_amdgcn_mfma_f32_32x32x16_bf16(b0, qr[d0], p0, 0, 0, 0);
    p1 = __builtin_amdgcn_mfma_f32_32x32x16_bf16(b1, qr[d0], p1, 0, 0, 0); }
}
__device__ __forceinline__ int v_st(int k, int c) { const int kk = (k & ~0xC) | ((k & 4) << 1) | ((k & 8) >> 1); return ((kk >> 3) * 4 + (c >> 5)) * 512 + ((kk & 7) * 32 + (c & 31)) * 2; }
__device__ __forceinline__ int v_rd_base(int lane) { return ((lane & 3) << 3) | (((lane >> 2) & 3) << 6) | (((lane >> 4) & 1) << 5) | (((lane >> 5) & 1) << 8); }
constexpr int v_rd_off(int d0, int ks, int half) { return d0 * 512 + ks * 4096 + half * 2048; }
template <int OFF> __device__ __forceinline__ s16x4 tr_read(int vb) {
  s16x4 r; asm volatile("ds_read_b64_tr_b16 %0, %1 offset:%2" : "=&v"(r) : "v"(vb), "i"(OFF) : "memory"); return r;
}
struct VFrag { s16x4 l0, h0, l1, h1, l2, h2, l3, h3; };
template <int D0> __device__ __forceinline__ void v_reads(VFrag& f, int vb) {
  f.l0 = tr_read<v_rd_off(D0, 0, 0)>(vb); f.h0 = tr_read<v_rd_off(D0, 0, 1)>(vb); f.l1 = tr_read<v_rd_off(D0, 1, 0)>(vb); f.h1 = tr_read<v_rd_off(D0, 1, 1)>(vb);
  f.l2 = tr_read<v_rd_off(D0, 2, 0)>(vb); f.h2 = tr_read<v_rd_off(D0, 2, 1)>(vb); f.l3 = tr_read<v_rd_off(D0, 3, 0)>(vb); f.h3 = tr_read<v_rd_off(D0, 3, 1)>(vb);
}
template <int VAR> __device__ __forceinline__ void pv_mma(f32x16& od, const VFrag& f, bf16x8 pa0, bf16x8 pa1, bf16x8 pa2, bf16x8 pa3) {
  if constexpr (AV_NOPV(VAR)) { asm volatile("" : "+v"(od)); return; }
#define PK(L, H) (bf16x8){L[0], L[1], L[2], L[3], H[0], H[1], H[2], H[3]}
  od = __builtin_amdgcn_mfma_f32_32x32x16_bf16(pa0, PK(f.l0, f.h0), od, 0, 0, 0);
  od = __builtin_amdgcn_mfma_f32_32x32x16_bf16(pa1, PK(f.l1, f.h1), od, 0, 0, 0);
  od = __builtin_amdgcn_mfma_f32_32x32x16_bf16(pa2, PK(f.l2, f.h2), od, 0, 0, 0);
  od = __builtin_amdgcn_mfma_f32_32x32x16_bf16(pa3, PK(f.l3, f.h3), od, 0, 0, 0);
#undef PK
}
#define LWAIT(n) do { asm volatile("s_waitcnt lgkmcnt(" #n ")" ::: "memory"); SBAR(); } while (0)
template <int VAR> __device__ __forceinline__ void pv_sm(f32x16* o, int vb, bf16x8 pa0, bf16x8 pa1, bf16x8 pa2, bf16x8 pa3, f32x16& p0, f32x16& p1, float& m_reg, float& alpha) {
  constexpr float C = SCALE * 1.4426950408889634f;
  VFrag fa, fb;
  v_reads<0>(fa, vb); v_reads<1>(fb, vb); LWAIT(8);
  pv_mma<VAR>(o[0], fa, pa0, pa1, pa2, pa3);
  if constexpr (AV_NOSM(VAR)) {
    v_reads<2>(fa, vb); LWAIT(8); pv_mma<VAR>(o[1], fb, pa0, pa1, pa2, pa3);
    v_reads<3>(fb, vb); LWAIT(8); pv_mma<VAR>(o[2], fa, pa0, pa1, pa2, pa3);
    LWAIT(0); pv_mma<VAR>(o[3], fb, pa0, pa1, pa2, pa3); alpha = 1.f; asm volatile("" : "+v"(p0), "+v"(p1)); return;
  }
  float pmax = p0[0];
#pragma unroll
  for (int r = 1; r < 16; ++r) pmax = fmaxf(pmax, p0[r]);
#pragma unroll
  for (int r = 0; r < 16; ++r) pmax = fmaxf(pmax, p1[r]);
  { auto rr = __builtin_amdgcn_permlane32_swap(__float_as_uint(pmax), __float_as_uint(pmax), false, false);
    pmax = fmaxf(__uint_as_float(rr[0]), __uint_as_float(rr[1])); }
  asm volatile("" : "+v"(pmax));
  v_reads<2>(fa, vb); LWAIT(8);
  pv_mma<VAR>(o[1], fb, pa0, pa1, pa2, pa3);
  const bool keep = __all(pmax - m_reg <= THR / SCALE);
  const float mn = keep ? m_reg : fmaxf(m_reg, pmax);
  alpha = keep ? 1.f : __builtin_amdgcn_exp2f((m_reg - mn) * C); m_reg = mn;
  const float mnC = -mn * C;
#pragma unroll
  for (int r = 0; r < 16; ++r) p0[r] = fmaf(p0[r], C, mnC);
#pragma unroll
  for (int r = 0; r < 16; ++r) p1[r] = fmaf(p1[r], C, mnC);
  asm volatile("" : "+v"(p0), "+v"(p1));
  v_reads<3>(fb, vb); LWAIT(8);
  pv_mma<VAR>(o[2], fa, pa0, pa1, pa2, pa3);
  if constexpr (VAR != 1) {
#pragma unroll
  for (int r = 0; r < 16; ++r) p0[r] = __builtin_amdgcn_exp2f(p0[r]); }
  asm volatile("" : "+v"(p0));
  LWAIT(0);
  pv_mma<VAR>(o[3], fb, pa0, pa1, pa2, pa3);
  if constexpr (VAR != 1) {
#pragma unroll
  for (int r = 0; r < 16; ++r) p1[r] = __builtin_amdgcn_exp2f(p1[r]); }
  asm volatile("" : "+v"(p1));
}
template <int VAR> __device__ __forceinline__ void pv_d0(f32x16* o, int vb, bf16x8 pa0, bf16x8 pa1, bf16x8 pa2, bf16x8 pa3) {
  VFrag fa, fb;
  v_reads<0>(fa, vb); v_reads<1>(fb, vb); LWAIT(8); pv_mma<VAR>(o[0], fa, pa0, pa1, pa2, pa3);
  v_reads<2>(fa, vb); LWAIT(8); pv_mma<VAR>(o[1], fb, pa0, pa1, pa2, pa3);
  v_reads<3>(fb, vb); LWAIT(8); pv_mma<VAR>(o[2], fa, pa0, pa1, pa2, pa3);
  LWAIT(0); pv_mma<VAR>(o[3], fb, pa0, pa1, pa2, pa3);
}
template <int VAR> __device__ __forceinline__ void attn_map(const int MAP, const bf16_t* __restrict__ Qb, const bf16_t* __restrict__ Kh, const bf16_t* __restrict__ Vh, float* O1b, bf16_t* Oab,
                                         const float* subg, float lam, int seq, char* lds) {
  const int tid = threadIdx.x, lane = tid & 63, r32 = lane & 31, hi = lane >> 5; const int wid = __builtin_amdgcn_readfirstlane(tid >> 6);
  char* V_lds = lds; char* K_lds = lds + NSLOT * SHM_V;
  float* ws = (float*)(lds + NSLOT * (SHM_V + SHM_K)) + wid * 64; float* li_l = ws; float* al_l = ws + 32;
  float m_reg = -1e30f, l_reg = 0; f32x16 o[4] = {}; bf16x8 qr[4];
  const bf16_t* Qw = Qb + (long)(wid * QBLK + r32) * LD + hi * 8;
  const bf16_t* ksrc; const bf16_t* vsrc0; const bf16_t* vsrc1;
  { const int p = wid * 64 + lane, row = p >> 3, ch = (p & 7) ^ ((row >> 1) & 7); ksrc = Kh + (long)row * LD + ch * 8; }
  { const int p = (2 * wid) * 64 + lane, sub = p >> 5, q = p & 31, kk = (sub >> 2) * 8 + (q >> 2), c = (sub & 3) * 32 + (q & 3) * 8, k = (kk & ~0xC) | ((kk & 4) << 1) | ((kk & 8) >> 1); vsrc0 = Vh + (long)k * LD + c; }
  { const int p = (2 * wid + 1) * 64 + lane, sub = p >> 5, q = p & 31, kk = (sub >> 2) * 8 + (q >> 2), c = (sub & 3) * 32 + (q & 3) * 8, k = (kk & ~0xC) | ((kk & 4) << 1) | ((kk & 8) >> 1); vsrc1 = Vh + (long)k * LD + c; }
  typedef __attribute__((address_space(3))) unsigned ldsu;
  ldsu* kdst = (ldsu*)(__attribute__((address_space(3))) char*)(K_lds) + wid * 256;
  ldsu* vdst = (ldsu*)(__attribute__((address_space(3))) char*)(V_lds) + wid * 512;
  const int NT = seq / KVBLK, TL = NT - 1;
#define DMA_K(t, slot) do { if constexpr (!AV_NOSTAGE(VAR)) { const int t_ = (t) < TL ? (t) : TL; \
    __builtin_amdgcn_global_load_lds((const unsigned*)(ksrc + (long)t_ * KVBLK * LD), kdst + (slot) * (int)(SHM_K / 4), 16, 0, 0); } } while (0)
#define DMA_V(t, slot) do { if constexpr (!AV_NOSTAGE(VAR)) { const int t_ = (t) < TL ? (t) : TL; \
    __builtin_amdgcn_global_load_lds((const unsigned*)(vsrc0 + (long)t_ * KVBLK * LD), vdst + (slot) * (int)(SHM_V / 4), 16, 0, 0); \
    __builtin_amdgcn_global_load_lds((const unsigned*)(vsrc1 + (long)t_ * KVBLK * LD), vdst + (slot) * (int)(SHM_V / 4) + 256, 16, 0, 0); } } while (0)
#define TILE_BAR(n) do { asm volatile("s_waitcnt vmcnt(" #n ") lgkmcnt(0)" ::: "memory"); if constexpr (!AV_NOSYNC(VAR)) __builtin_amdgcn_s_barrier(); asm volatile("" ::: "memory"); } while (0)
#define RESC(a) do { if (__any((a) < 1.f)) { if (hi == 0) al_l[r32] = (a); asm volatile("s_waitcnt lgkmcnt(0)" ::: "memory"); \
    _Pragma("unroll") for (int d = 0; d < 4; ++d) _Pragma("unroll") for (int r = 0; r < 16; ++r) o[d][r] *= al_l[crow(r, hi)]; } } while (0)
  DMA_K(0, 0); DMA_V(0, 0); DMA_K(1, 1);
#pragma unroll
  for (int d0 = 0; d0 < 4; ++d0) qr[d0] = *reinterpret_cast<const bf16x8*>(Qw + d0 * 16);
  const int vb0 = (int)(uintptr_t)V_lds + v_rd_base(lane);
  f32x16 pA0, pA1, pB0, pB1; float mnA, alA, alB; bf16x8 pa0, pa1, pa2, pa3;
  TILE_BAR(0);
  int kc = 0, vp = 2;
#define NEXT3(x) ((x) == 2 ? 0 : (x) + 1)
#define PREV3(x) ((x) == 0 ? 2 : (x) - 1)
  DMA_K(2, PREV3(kc)); DMA_V(1, NEXT3(NEXT3(vp)));
  qkt<VAR>(pA0, pA1, K_lds + kc * SHM_K, qr, r32, hi); partialSM(pA0, pA1, m_reg, mnA, alA);
  TILE_BAR(3); kc = NEXT3(kc); vp = NEXT3(vp);
  for (int j = 1; j + 1 < NT; j += 2) {
    DMA_K(j + 2, PREV3(kc)); DMA_V(j + 1, NEXT3(NEXT3(vp)));
    SBAR(); qkt<VAR>(pB0, pB1, K_lds + kc * SHM_K, qr, r32, hi);
    finishSM<VAR>(pA0, pA1, alA, l_reg, pa0, pa1, pa2, pa3); SBAR();
    pv_sm<VAR>(o, vb0 + vp * (int)SHM_V, pa0, pa1, pa2, pa3, pB0, pB1, m_reg, alB);
    RESC(alB); TILE_BAR(3); kc = NEXT3(kc); vp = NEXT3(vp);
    DMA_K(j + 3, PREV3(kc)); DMA_V(j + 2, NEXT3(NEXT3(vp)));
    SBAR(); qkt<VAR>(pA0, pA1, K_lds + kc * SHM_K, qr, r32, hi);
    finishSM<VAR>(pB0, pB1, alB, l_reg, pa0, pa1, pa2, pa3); SBAR();
    pv_sm<VAR>(o, vb0 + vp * (int)SHM_V, pa0, pa1, pa2, pa3, pA0, pA1, m_reg, alA);
    RESC(alA); TILE_BAR(3); kc = NEXT3(kc); vp = NEXT3(vp);
  }
  DMA_K(NT, PREV3(kc)); DMA_V(NT, NEXT3(NEXT3(vp)));
  SBAR(); qkt<VAR>(pB0, pB1, K_lds + kc * SHM_K, qr, r32, hi);
  finishSM<VAR>(pA0, pA1, alA, l_reg, pa0, pa1, pa2, pa3); SBAR();
  pv_sm<VAR>(o, vb0 + vp * (int)SHM_V, pa0, pa1, pa2, pa3, pB0, pB1, m_reg, alB);
  RESC(alB); TILE_BAR(3); vp = NEXT3(vp);
  finishSM<VAR>(pB0, pB1, alB, l_reg, pa0, pa1, pa2, pa3); SBAR();
  pv_d0<VAR>(o, vb0 + vp * (int)SHM_V, pa0, pa1, pa2, pa3);
  TILE_BAR(0);
  if (hi == 0) li_l[r32] = l_reg; asm volatile("s_waitcnt lgkmcnt(0)" ::: "memory");
  float rli[16];
#pragma unroll
  for (int r = 0; r < 16; ++r) rli[r] = __builtin_amdgcn_rcpf(li_l[crow(r, hi)]);
  int r32e = r32, hie = hi, wide = wid, lanee = lane; asm volatile("" : "+v"(r32e), "+v"(hie), "+v"(wide), "+v"(lanee));
  u32x4* o1l = (u32x4*)(lds + SHM_ATTN) + wide * 512 + lanee;
  if (MAP == 0) {
#pragma unroll
    for (int d0 = 0; d0 < 4; ++d0)
#pragma unroll
      for (int g = 0; g < 2; ++g) { u32x4 w;
#pragma unroll
        for (int q = 0; q < 4; ++q) { const int r = g * 8 + 2 * q; w[q] = cvtpk(o[d0][r] * rli[r], o[d0][r + 1] * rli[r + 1]); }
        o1l[(d0 * 2 + g) * 64] = w; }
  } else {
    float sg[4];
#pragma unroll
    for (int d0 = 0; d0 < 4; ++d0) sg[d0] = subg[d0 * 32 + r32e] * (1.f - LAM_INIT);
    bf16_t* Oa = Oab + (long)(wide * QBLK) * LD;
#pragma unroll
    for (int d0 = 0; d0 < 4; ++d0)
#pragma unroll
      for (int g = 0; g < 2; ++g) { const u32x4 w = o1l[(d0 * 2 + g) * 64];
#pragma unroll
        for (int q = 0; q < 4; ++q) { const int r = g * 8 + 2 * q;
          o[d0][r] = __uint_as_float(w[q] << 16) - lam * (o[d0][r] * rli[r]); o[d0][r + 1] = __uint_as_float(w[q] & 0xffff0000u) - lam * (o[d0][r + 1] * rli[r + 1]); } }
#pragma unroll
    for (int rg = 0; rg < 4; ++rg) {
      float ss[4];
#pragma unroll
      for (int q = 0; q < 4; ++q) { const int r = rg * 4 + q; float s_ = 0.f;
#pragma unroll
        for (int d0 = 0; d0 < 4; ++d0) s_ += o[d0][r] * o[d0][r];
        ss[q] = s_; }
#pragma unroll
      for (int sft = 1; sft < 32; sft <<= 1)
#pragma unroll
        for (int q = 0; q < 4; ++q) ss[q] += __shfl_xor(ss[q], sft);
#pragma unroll
      for (int q = 0; q < 4; ++q) { const int r = rg * 4 + q, orow = crow(r, hie); const float rs = __builtin_amdgcn_rsqf(ss[q] * (1.f / 128.f) + EPS);
#pragma unroll
        for (int d0 = 0; d0 < 4; ++d0) Oa[(long)orow * LD + d0 * 32 + r32e] = (bf16_t)f2bf(o[d0][r] * rs * sg[d0]); }
    }
  }
#undef DMA_K
#undef DMA_V
#undef TILE_BAR
#undef NEXT3
#undef PREV3
#undef RESC
}
#undef SBAR
}

constexpr int CW_TMO = 0, CW_CODE = 1;
constexpr int CW_BAR = 4096;
#define XB_TMO      128
#define XB_XCNT(j)  (256  + 64 * (j))
#define XB_XSUB(j)  (1280 + 64 * (j))
#define XB_XGEN(j)  (2304 + 64 * (j))
#define XB_TOP      3328
#define XB_TOPGEN   3392
#define XCD_BAR_WORDS 3456
#define XB_SPIN_CAP (1u << 18)
__device__ __forceinline__ unsigned xb_ld(unsigned* p)              { return __hip_atomic_load(p, __ATOMIC_RELAXED, __HIP_MEMORY_SCOPE_AGENT); }
__device__ __forceinline__ unsigned xb_add(unsigned* p, unsigned v) { return __hip_atomic_fetch_add(p, v, __ATOMIC_RELAXED, __HIP_MEMORY_SCOPE_AGENT); }
__device__ __forceinline__ unsigned xb_xcc_id() { return (unsigned)__builtin_amdgcn_s_getreg((3 << 11) | 20) & 0xFu; }
#define XB_SPIN(cond, bar) do { unsigned _sp = 0; while (cond) { __builtin_amdgcn_s_sleep(1); \
    if ((++_sp & 255u) == 0u) { if (xb_ld(&(bar)[XB_TMO])) break; if (_sp > XB_SPIN_CAP) { atomicAdd(&(bar)[XB_TMO], 1u); break; } } } } while (0)
struct XcdBarrier { unsigned* bar; unsigned x; volatile LAS unsigned* st; };
__device__ __forceinline__ XcdBarrier xcd_barrier_post(unsigned* bar, volatile LAS unsigned* st) {
    XcdBarrier b; b.bar = bar; b.x = xb_xcc_id(); b.st = st;
    if (threadIdx.x == 0) (void)xb_add(&bar[XB_XCNT(b.x)], 1u);
    return b;
}
__device__ __forceinline__ void xcd_barrier_complete(unsigned* bar, unsigned x, unsigned& nloc, unsigned& nx) {
    const unsigned G = gridDim.x * gridDim.y * gridDim.z;
    unsigned sum, cnt, mine, sp = 0u;
    for (;;) {
        sum = 0u; cnt = 0u; mine = 0u;
#pragma unroll
        for (unsigned j = 0; j < 16; ++j) { const unsigned c = xb_ld(&bar[XB_XCNT(j)]); sum += c; cnt += (c > 0u) ? 1u : 0u; mine = (j == x) ? c : mine; }
        if (sum == G) break;
        __builtin_amdgcn_s_sleep(1);
        if ((++sp & 255u) == 0u) { if (xb_ld(&bar[XB_TMO])) break; if (sp > XB_SPIN_CAP) { atomicAdd(&bar[XB_TMO], 1u); break; } }
    }
    nloc = mine > 0u ? mine : 1u; nx = cnt > 0u ? cnt : 1u;
}
__device__ __forceinline__ void xcd_barrier(const XcdBarrier& b) {
    asm volatile("s_waitcnt vmcnt(0)" ::: "memory");
    __syncthreads();
    if (threadIdx.x == 0) {
        unsigned* bar = b.bar;
        __builtin_amdgcn_s_waitcnt(0);
        unsigned nloc = b.st[0], nx = b.st[1];
        if (nloc == 0u) { xcd_barrier_complete(bar, b.x, nloc, nx); b.st[0] = nloc; b.st[1] = nx; }
        const unsigned old = xb_add(&bar[XB_XSUB(b.x)], 1u);
        __builtin_amdgcn_fence(__ATOMIC_ACQUIRE, "agent");
        const unsigned gen = old / nloc;
        if (old + 1u == (gen + 1u) * nloc) {
            __builtin_amdgcn_fence(__ATOMIC_RELEASE, "agent");
            asm volatile("s_waitcnt vmcnt(0)" ::: "memory");
            const unsigned og = xb_add(&bar[XB_TOP], 1u);
            const unsigned tg = og / nx;
            if (og + 1u == (tg + 1u) * nx) xb_add(&bar[XB_TOPGEN], 1u);
            else XB_SPIN(xb_ld(&bar[XB_TOPGEN]) == tg, bar);
            xb_add(&bar[XB_XGEN(b.x)], 1u);
            asm volatile("s_waitcnt vmcnt(0)" ::: "memory");
        } else {
            XB_SPIN(xb_ld(&bar[XB_XGEN(b.x)]) == gen, bar);
            asm volatile("s_waitcnt vmcnt(0)" ::: "memory");
        }
    }
    __syncthreads();
}

constexpr int NWAVES = 8;
struct Args { const float* in[23]; float* out; unsigned char* ws; int ph_lo, ph_hi, li, pad; };
struct Frame {
    LAS unsigned char* lds;
    int tid, lane, wave, vcu, G;
    unsigned char* ws;
};

__device__ __forceinline__ void transpose_item(const float* W, int K, int N, bf16_t* WT, int k0, int n0, int rowbase, LAS float* scr, int lane) {
    float tv[32];
    const float* wp = W + (size_t)(k0 + (lane >> 5)) * N + n0 + (lane & 31);
#pragma unroll
    for (int i = 0; i < 32; ++i) tv[i] = __builtin_nontemporal_load(wp + (size_t)(2 * i) * N);
#pragma unroll
    for (int i = 0; i < 32; ++i) scr[(2 * i + (lane >> 5)) * 33 + (lane & 31)] = tv[i];
    LDS_WAIT(); asm volatile("" ::: "memory");
    const int c = lane & 7;
#pragma unroll
    for (int j = 0; j < 4; ++j) { const int n = (lane >> 3) + 8 * j; const LAS float* s = scr + (8 * c) * 33 + n;
        v4u o; o.x = pk2(s[0 * 33], s[1 * 33]); o.y = pk2(s[2 * 33], s[3 * 33]); o.z = pk2(s[4 * 33], s[5 * 33]); o.w = pk2(s[6 * 33], s[7 * 33]);
        *(GAS v4u*)(WT + (size_t)(rowbase + n) * K + k0 + 8 * c) = o; }
    LDS_WAIT(); asm volatile("" ::: "memory");
}

constexpr int FP8_SCR_STRIDE = 128 * 33 * 4;
__device__ __forceinline__ void transpose_item_fp8(const float* W, int K, int N, unsigned char* WT, int k0, int n0, int rowbase, LAS float* scr, int lane, const float wsc = 16.f) {
    const float* wp = W + (size_t)(k0 + (lane >> 5)) * N + n0 + (lane & 31);
    { float tv[64];
#pragma unroll
        for (int i = 0; i < 64; ++i) tv[i] = __builtin_nontemporal_load(wp + (size_t)(2 * i) * N);
#pragma unroll
        for (int i = 0; i < 64; ++i) scr[(2 * i + (lane >> 5)) * 33 + (lane & 31)] = tv[i]; }
    LDS_WAIT(); asm volatile("" ::: "memory");
    const int c = lane & 7;
#pragma unroll
    for (int j = 0; j < 4; ++j) { const int n = (lane >> 3) + 8 * j; const LAS float* s = scr + (16 * c) * 33 + n;
        v4u o;
#pragma unroll
        for (int q = 0; q < 4; ++q) o[q] = pk_fp8x4(wsc * s[(4 * q) * 33], wsc * s[(4 * q + 1) * 33], wsc * s[(4 * q + 2) * 33], wsc * s[(4 * q + 3) * 33]);
        *(GAS v4u*)(WT + (size_t)(rowbase + n) * K + k0 + 16 * c) = o; }
    LDS_WAIT(); asm volatile("" ::: "memory");
}
__device__ __forceinline__ void p0_prologue(Frame& F, const Args& a) {
    float* mods = (float*)(F.ws + WS_MODS);
    for (int item = blockIdx.x; item < NMOD / 64; item += F.G) {
        LAS float* sil = (LAS float*)F.lds; LAS float* red = sil + 9 * DM;
        for (int i = F.tid; i < 9 * DM; i += 512) { const float v = i < 8 * DM ? a.in[1][i] : a.in[3][i - 8 * DM]; sil[i] = v * sigmoidf_(v); }
        __syncthreads();
        const float* wa = a.in[6] + 64 * item + F.lane; float acc[9];
#pragma unroll
        for (int b = 0; b < 9; ++b) acc[b] = 0.f;
        const int kb = F.wave * 128;
#pragma unroll 8
        for (int k = kb; k < kb + 128; ++k) { const float wv = wa[(size_t)k * NMOD];
#pragma unroll
            for (int b = 0; b < 9; ++b) acc[b] += sil[b * DM + k] * wv; }
#pragma unroll
        for (int b = 0; b < 9; ++b) red[(F.wave * 9 + b) * 64 + F.lane] = acc[b];
        __syncthreads();
        for (int i = F.tid; i < 9 * 64; i += 512) { const int b = i >> 6, l = i & 63; float s = 0.f;
#pragma unroll
            for (int w = 0; w < 8; ++w) s += red[(w * 9 + b) * 64 + l];
            mods[(size_t)b * NMOD + 64 * item + l] = s + a.in[7][64 * item + l]; }
        __syncthreads();
    }
    LAS float* scr = (LAS float*)(F.lds + F.wave * 16384);
    const int gw = F.vcu * NWAVES + F.wave, NGW = F.G * NWAVES;
    constexpr int I_IN = (DM / 64) * (8 * DM / 32), I_SQ = (DM / 64) * (DM / 32);
    for (int it = gw; it < I_IN + 3 * I_SQ; it += NGW) {
        if (it < I_IN) { const int nblk = 8 * DM / 32, kb = it / nblk, nb = it % nblk, c0 = 32 * nb, part = c0 >> 10, j0 = c0 & 1023;
            const int rb = part == 0 ? (j0 >> 7) * 256 + (j0 & 127) : part == 2 ? (j0 >> 7) * 256 + 128 + (j0 & 127) : part == 1 ? 2048 + j0 : c0;
            transpose_item(a.in[8], DM, 8 * DM, (bf16_t*)(F.ws + WS_WIN), 64 * kb, c0, rb, scr, F.lane); }
        else { const int r = it - I_IN, which = r / I_SQ, q = r % I_SQ, kb = q / 32, nb = q % 32;
            const float* W = which == 0 ? a.in[10] : which == 1 ? a.in[16] : a.in[17];
            bf16_t* WT = (bf16_t*)(F.ws + (which == 0 ? WS_WC : which == 1 ? WS_WO : WS_WOUT));
            transpose_item(W, DM, DM, WT, 64 * kb, 32 * nb, 32 * nb, scr, F.lane); }
    }
}
__device__ __forceinline__ void p1_norm(Frame& F, const Args& a) {
    const float* mods = (const float*)(F.ws + WS_MODS); bf16_t* A1 = (bf16_t*)(F.ws + WS_A1);
    const int gw = F.vcu * NWAVES + F.wave, NGW = F.G * NWAVES;
    for (int row = gw; row < MA; row += NGW) {
        const float* xr = row < MX ? a.in[0] + (size_t)row * DM : a.in[2] + (size_t)(row - MX) * DM;
        const int b = row < MX ? row >> 11 : 8;
        const f32x4* xv = (const f32x4*)xr + F.lane; f32x4 v[4]; float s = 0.f;
#pragma unroll
        for (int j = 0; j < 4; ++j) { v[j] = xv[64 * j]; s += (v[j].x * v[j].x + v[j].y * v[j].y) + (v[j].z * v[j].z + v[j].w * v[j].w); }
        const float rstd = __builtin_amdgcn_rsqf(wave_sum(s) * (1.f / DM) + EPS);
        const f32x4* gv = (const f32x4*)a.in[4] + F.lane; const f32x4* shv = (const f32x4*)(mods + (size_t)b * NMOD) + F.lane; const f32x4* scv = (const f32x4*)(mods + (size_t)b * NMOD + DM) + F.lane;
        v2u* o8 = (v2u*)(A1 + (size_t)row * DM) + F.lane;
#pragma unroll
        for (int j = 0; j < 4; ++j) { const f32x4 y = (v[j] * rstd * gv[64 * j]) * (scv[64 * j] + 1.f) + shv[64 * j];
            v2u w; w.x = pk2(y.x, y.y); w.y = pk2(y.z, y.w); o8[64 * j] = w; }
    }
}
__device__ __forceinline__ void p3_conv(Frame& F, const Args& a) {
    const bf16_t* Z = (const bf16_t*)(F.ws + WS_Z); const bf16_t* GB = (const bf16_t*)(F.ws + WS_GB); bf16_t* AC = (bf16_t*)(F.ws + WS_A1);
    const int gw = F.vcu * NWAVES + F.wave, NGW = F.G * NWAVES;
    const float* cw = a.in[9];
    for (int grp = gw; grp < MX / 8; grp += NGW) {
#pragma unroll
        for (int half = 0; half < 2; ++half) {
            const int col = half * 512 + F.lane * 8;
            f32x4 w0[2], w1[2], w2[2];
#pragma unroll
            for (int i = 0; i < 2; ++i) { w0[i] = *(const f32x4*)(cw + col + 4 * i); w1[i] = *(const f32x4*)(cw + DM + col + 4 * i); w2[i] = *(const f32x4*)(cw + 2 * DM + col + 4 * i); }
            const int r0 = grp * 8; f32x4 zp[2], zc[2], zn[2];
            if ((r0 & (SEQ - 1)) == 0) { zp[0] = (f32x4){0.f, 0.f, 0.f, 0.f}; zp[1] = zp[0]; } else pg8::unpack8(*(const v4u*)(Z + (size_t)(r0 - 1) * DM + col), zp[0], zp[1]);
            pg8::unpack8(*(const v4u*)(Z + (size_t)r0 * DM + col), zc[0], zc[1]);
#pragma unroll
            for (int r = 0; r < 8; ++r) { const int row = r0 + r;
                if ((row & (SEQ - 1)) == SEQ - 1) { zn[0] = (f32x4){0.f, 0.f, 0.f, 0.f}; zn[1] = zn[0]; } else pg8::unpack8(*(const v4u*)(Z + (size_t)(row + 1) * DM + col), zn[0], zn[1]);
                f32x4 g0, g1; pg8::unpack8(*(const v4u*)(GB + (size_t)row * DM + col), g0, g1);
                const f32x4 y0 = g0 * (zp[0] * w0[0] + zc[0] * w1[0] + zn[0] * w2[0]), y1 = g1 * (zp[1] * w0[1] + zc[1] * w1[1] + zn[1] * w2[1]);
                *(v4u*)(AC + (size_t)row * DM + col) = pg8::pack8(y0, y1);
                zp[0] = zc[0]; zp[1] = zc[1]; zc[0] = zn[0]; zc[1] = zn[1]; }
        }
    }
}
template <int VAR> __device__ __forceinline__ void p3_attn(Frame& F, const Args& a, char* lds) {
    float s1 = 0.f, s2 = 0.f;
    for (int i = 0; i < 64; ++i) { s1 += a.in[11][i] * a.in[12][i]; s2 += a.in[13][i] * a.in[14][i]; }
    const float lam = __expf(s1) - __expf(s2) + LAM_INIT;
    const bf16_t* Q = (const bf16_t*)(F.ws + WS_Q); const bf16_t* KA = (const bf16_t*)(F.ws + WS_KALL); const bf16_t* VA = (const bf16_t*)(F.ws + WS_VALL);
    float* O1 = (float*)(F.ws + WS_O1); bf16_t* OA = (bf16_t*)(F.ws + (VAR < 0 ? WS_OATT : WS_MERGED));
    for (int it = 2 * F.vcu; it < 2 * NB * NH * 8; it += 2 * F.G + ((it & 1) ? -1 : 1) - ((it & 1) ? 0 : 2 * F.G)) {
        const int u = it >> 1, map = it & 1;
        const int bh = u >> 3, qb = u & 7, b = bh >> 3, h = bh & 7;
        const size_t qrow = (size_t)b * SEQ + qb * 256, krow = (size_t)b * SKV;
        att::attn_map<VAR>(map, Q + qrow * DM + h * 128 + map * 64, KA + krow * DM + h * 128 + map * 64, VA + krow * DM + h * 128, O1 + qrow * DM + h * 128, OA + qrow * DM + h * 128, a.in[15], lam, SKV, lds);
    }
}
__device__ __forceinline__ void p6_norm_router(Frame& F, const Args& a) {
    const float* mods = (const float*)(F.ws + WS_MODS); unsigned char* HX = (unsigned char*)(F.ws + WS_HX2);   float* aff = (float*)(F.ws + WS_AFF);
    LAS float* wrT = (LAS float*)F.lds;
    for (int i = F.tid; i < DM * NE; i += 512) wrT[(i & 15) * DM + (i >> 4)] = a.in[18][i];
    __syncthreads();
    const int gw = F.vcu * NWAVES + F.wave, NGW = F.G * NWAVES;
    const f32x4* gv = (const f32x4*)a.in[5] + F.lane;
    const bool b5 = F.lane & 32, b4 = F.lane & 16, b3 = F.lane & 8, b2 = F.lane & 4;
    for (int grp = gw; grp < MX / 8; grp += NGW) {
        const int b = (grp * 8) >> 11;
        const f32x4* shv = (const f32x4*)(mods + (size_t)b * NMOD + 3 * DM) + F.lane; const f32x4* scv = (const f32x4*)(mods + (size_t)b * NMOD + 4 * DM) + F.lane; f32x4 sh[4], sc[4];
#pragma unroll
        for (int j = 0; j < 4; ++j) { sh[j] = shv[64 * j]; sc[j] = (scv[64 * j] + 1.f) * gv[64 * j]; }
        const bf16_t* MIX = (const bf16_t*)(F.ws + WS_MIX);
        f32x4 vn[2][4]; v2u mn_[2][4];
#pragma unroll
        for (int t = 0; t < 2; ++t) { const f32x4* xv = (const f32x4*)(a.in[0] + (size_t)(grp * 8 + t) * DM) + F.lane; const v2u* mv = (const v2u*)(MIX + (size_t)(grp * 8 + t) * DM) + F.lane;
#pragma unroll
          for (int j = 0; j < 4; ++j) { vn[t][j] = xv[64 * j]; mn_[t][j] = mv[64 * j]; } }
#pragma unroll 1
        for (int rp = 0; rp < 4; ++rp) { const int row = grp * 8 + 2 * rp;
            f32x4 v[2][4]; float s[2] = {0.f, 0.f};
#pragma unroll
            for (int t = 0; t < 2; ++t)
#pragma unroll
                for (int j = 0; j < 4; ++j) { v[t][j] = vn[t][j] + (f32x4){bf_lo(mn_[t][j].x), bf_hi(mn_[t][j].x), bf_lo(mn_[t][j].y), bf_hi(mn_[t][j].y)};
                    s[t] += (v[t][j].x * v[t][j].x + v[t][j].y * v[t][j].y) + (v[t][j].z * v[t][j].z + v[t][j].w * v[t][j].w); }
            if (rp < 3) {
#pragma unroll
                for (int t = 0; t < 2; ++t) { const f32x4* xv = (const f32x4*)(a.in[0] + (size_t)(row + 2 + t) * DM) + F.lane; const v2u* mv = (const v2u*)(MIX + (size_t)(row + 2 + t) * DM) + F.lane;
#pragma unroll
                    for (int j = 0; j < 4; ++j) { vn[t][j] = xv[64 * j]; mn_[t][j] = mv[64 * j]; } } }
#pragma unroll
            for (int t = 0; t < 2; ++t) { const float rstd = __builtin_amdgcn_rsqf(wave_sum(s[t]) * (1.f / DM) + EPS);
                unsigned* o8 = (unsigned*)(HX + (size_t)(row + t) * DM) + F.lane;
#pragma unroll
                for (int j = 0; j < 4; ++j) { v[t][j] = (v[t][j] * rstd) * sc[j] + sh[j];
                    o8[64 * j] = pk_fp8x4(v[t][j].x, v[t][j].y, v[t][j].z, v[t][j].w); } }
            f32x2 vv[16];
#pragma unroll
            for (int j = 0; j < 4; ++j)
#pragma unroll
                for (int c = 0; c < 4; ++c) vv[4 * j + c] = (f32x2){v[0][j][c], v[1][j][c]};
            float p[2][NE];
#pragma unroll
            for (int eg = 0; eg < NE; eg += 2) {
#pragma unroll
                for (int e = eg; e < eg + 2; ++e) { f32x2 q = {0.f, 0.f};
#pragma unroll
                    for (int j = 0; j < 4; ++j) { const f32x4 w = *(const LAS f32x4*)(wrT + e * DM + 256 * j + 4 * F.lane);
#pragma unroll
                        for (int c = 0; c < 4; ++c) q = __builtin_elementwise_fma(vv[4 * j + c], (f32x2){w[c], w[c]}, q); }
                    p[0][e] = q.x; p[1][e] = q.y; }
                asm volatile("" ::: "memory"); }
#pragma unroll
            for (int t = 0; t < 2; ++t) {
                float q8[8], q4[4], q2[2], q1;
#pragma unroll
                for (int i = 0; i < 8; ++i) { const float keep = b5 ? p[t][i + 8] : p[t][i], send = b5 ? p[t][i] : p[t][i + 8]; q8[i] = keep + __shfl_xor(send, 32); }
#pragma unroll
                for (int i = 0; i < 4; ++i) { const float keep = b4 ? q8[i + 4] : q8[i], send = b4 ? q8[i] : q8[i + 4]; q4[i] = keep + __shfl_xor(send, 16); }
#pragma unroll
                for (int i = 0; i < 2; ++i) { const float keep = b3 ? q4[i + 2] : q4[i], send = b3 ? q4[i] : q4[i + 2]; q2[i] = keep + __shfl_xor(send, 8); }
                { const float keep = b2 ? q2[1] : q2[0], send = b2 ? q2[0] : q2[1]; q1 = keep + __shfl_xor(send, 4); }
                q1 += __shfl_xor(q1, 1); q1 += __shfl_xor(q1, 2);
                float mx = q1;
#pragma unroll
                for (int sft = 4; sft < 64; sft <<= 1) mx = fmaxf(mx, __shfl_xor(mx, sft));
                const float ex = __expf(q1 - mx); float den = ex;
#pragma unroll
                for (int sft = 4; sft < 64; sft <<= 1) den += __shfl_xor(den, sft);
                if ((F.lane & 3) == 0) aff[(size_t)(row + t) * NE + (F.lane >> 2)] = ex / den;
            }
        }
    }
    __syncthreads();
}
__device__ __forceinline__ void p7_topk_item(Frame& F, int item) {
    const int b = item >> 4, e = item & 15;
    const float* aff = (const float*)(F.ws + WS_AFF); int* slot = (int*)(F.ws + WS_SLOT); float* gate = (float*)(F.ws + WS_GATE); int* gidx = (int*)(F.ws + WS_GIDX);
    LAS unsigned* hist = (LAS unsigned*)F.lds;
    LAS unsigned* bc = hist + 256;
    LAS unsigned* wtot = hist + 288;
    unsigned v[4];
#pragma unroll
    for (int c = 0; c < 4; ++c) v[c] = __builtin_bit_cast(unsigned, aff[((size_t)b * SEQ + F.tid + 512 * c) * NE + e]);
    unsigned prefix = 0, need = CAP;
#pragma unroll 1
    for (int pass = 3; pass >= 0; --pass) {
        if (F.tid < 256) hist[F.tid] = 0u;
        __syncthreads();
        const int sh = 8 * pass;
#pragma unroll
        for (int c = 0; c < 4; ++c) if (pass == 3 || (v[c] >> (sh + 8)) == prefix) atomicAdd((unsigned*)&hist[(v[c] >> sh) & 255u], 1u);
        __syncthreads();
        if (F.wave == 0) {
            const unsigned h0 = hist[4 * F.lane], h1 = hist[4 * F.lane + 1], h2 = hist[4 * F.lane + 2], h3 = hist[4 * F.lane + 3], tot = (h0 + h1) + (h2 + h3);
            unsigned inc = tot;
#pragma unroll
            for (int d = 1; d < 64; d <<= 1) { const unsigned t = __shfl_down(inc, d); if (F.lane + d < 64) inc += t; }
            const unsigned a3 = inc - tot, a2 = a3 + h3, a1 = a2 + h2, a0 = a1 + h1;
            if (a3 < need && need <= a3 + h3) { bc[0] = 4 * F.lane + 3; bc[1] = a3; }
            else if (a2 < need && need <= a2 + h2) { bc[0] = 4 * F.lane + 2; bc[1] = a2; }
            else if (a1 < need && need <= a1 + h1) { bc[0] = 4 * F.lane + 1; bc[1] = a1; }
            else if (a0 < need && need <= a0 + h0) { bc[0] = 4 * F.lane; bc[1] = a0; }
        }
        __syncthreads();
        prefix = (prefix << 8) | bc[0]; need -= bc[1];
        __syncthreads();
    }
    const unsigned T = prefix;
    unsigned wpre[4];
    const unsigned long long ltmask = (1ull << F.lane) - 1ull;
#pragma unroll
    for (int c = 0; c < 4; ++c) { const unsigned long long bg = __ballot(v[c] > T), be = __ballot(v[c] == T);
        wpre[c] = (unsigned)__builtin_popcountll(bg & ltmask) | ((unsigned)__builtin_popcountll(be & ltmask) << 16);
        if (F.lane == 0) wtot[c * 8 + F.wave] = (unsigned)__builtin_popcountll(bg) | ((unsigned)__builtin_popcountll(be) << 16); }
    __syncthreads();
    if (F.wave == 0) { unsigned x = F.lane < 32 ? wtot[F.lane] : 0u, inc = x;
#pragma unroll
        for (int d = 1; d < 32; d <<= 1) { const unsigned t = __shfl_up(inc, d); if (F.lane >= d) inc += t; }
        if (F.lane < 32) wtot[F.lane] = inc - x; }
    __syncthreads();
    const int xsrow0 = (e * NB + b) * CAP;
#pragma unroll
    for (int c = 0; c < 4; ++c) { const unsigned pre = wtot[c * 8 + F.wave] + wpre[c], pgt = pre & 0xffffu, peq = pre >> 16; const int tok = F.tid + 512 * c;
        const bool sel = v[c] > T || (v[c] == T && peq < need);
        const int sidx = (int)(pgt + (peq < need ? peq : need));
        slot[(size_t)(b * NE + e) * SEQ + tok] = sel ? sidx : -1;
        if (sel) { gate[xsrow0 + sidx] = __builtin_bit_cast(float, v[c]); gidx[xsrow0 + sidx] = b * SEQ + tok; } }
    __syncthreads();
}
constexpr int N_WGU_ITEMS = NE * 1024, N_WD_ITEMS = NE * 512, WD_EARLY_PER_WAVE = 3, WD_EARLY = 192 * NWAVES * WD_EARLY_PER_WAVE;
__device__ __forceinline__ void wgu_item(Frame& F, const Args& a, int it, LAS float* scr) {
    const int e = it >> 10, r = it & 1023, which = r >> 9, q = r & 511, kb = q >> 6, nb = q & 63, n0 = 32 * nb;
    transpose_item_fp8(a.in[19 + which] + (size_t)e * DM * FH, DM, FH, (unsigned char*)(F.ws + WS_WGU), 128 * kb, n0, e * 4096 + (n0 >> 7) * 256 + (n0 & 127) + which * 128, scr, F.lane,
                       which == 0 ? -16.f * 1.4426950408889634f : -16.f / 1.4426950408889634f);
}
__device__ __forceinline__ void wd_item(Frame& F, const Args& a, int w, LAS float* scr) {
    const int e = w >> 9, q = w & 511, kb = q >> 5, nb = q & 31;
    transpose_item_fp8(a.in[21] + (size_t)e * FH * DM, FH, DM, (unsigned char*)(F.ws + WS_WD), 128 * kb, 32 * nb, e * DM + 32 * nb, scr, F.lane);
}
__device__ __forceinline__ void p7_moe_weight_item(Frame& F, const Args& a, int it, int wd0, LAS float* scr) {
    if (it < N_WGU_ITEMS) wgu_item(F, a, it, scr); else wd_item(F, a, wd0 + (it - N_WGU_ITEMS), scr);
}
constexpr int NIT7 = N_WGU_ITEMS + N_WD_ITEMS - WD_EARLY, Y3 = 6, N3 = 256 * NWAVES * Y3, XA7 = 3, XB7 = 5;
static_assert(N3 <= NIT7 && N3 + 128 * NWAVES * (XA7 + XB7) >= NIT7, "MoE weight item split");
__device__ __forceinline__ void p3_weight_share(Frame& F, const Args& a) {
    if (F.G != 256) return;
    LAS float* scr = (LAS float*)(F.lds + F.wave * FP8_SCR_STRIDE);
    const int start = F.vcu * NWAVES * Y3 + F.wave;
    for (int it = start; it < start + NWAVES * Y3; it += NWAVES) p7_moe_weight_item(F, a, it, WD_EARLY, scr);
}
__device__ __forceinline__ void p7_topk_weights(Frame& F, const Args& a) {
    LAS float* scr = (LAS float*)(F.lds + F.wave * FP8_SCR_STRIDE);
    if (F.G == 256) {
        if (!(F.vcu & 1)) p7_topk_item(F, F.vcu >> 1);
        const int cnt = (F.vcu & 1) ? XB7 : XA7, start = N3 + ((F.vcu & 1) ? 128 * NWAVES * XA7 : 0) + (F.vcu >> 1) * NWAVES * cnt + F.wave;
        for (int it = start; it < start + NWAVES * cnt && it < NIT7; it += NWAVES) p7_moe_weight_item(F, a, it, WD_EARLY, scr);
    } else {
        for (int item = F.vcu; item < NB * NE; item += F.G) p7_topk_item(F, item);
        const int gw = F.vcu * NWAVES + F.wave, NGW = F.G * NWAVES;
        for (int it = gw; it < N_WGU_ITEMS + N_WD_ITEMS; it += NGW) p7_moe_weight_item(F, a, it, 0, scr);
    }
}
template <bool DRY> __device__ __forceinline__ void p10_final(Frame& F, const Args& a) {
    const float* mods = (const float*)(F.ws + WS_MODS); const int* slot = (const int*)(F.ws + WS_SLOT); const bf16_t* YG = (const bf16_t*)(F.ws + WS_YG);
    const int gw = F.vcu * NWAVES + F.wave, NGW = F.G * NWAVES;
    const f32x4* fgv = (const f32x4*)a.in[22] + F.lane; f32x4 fg[4];
#pragma unroll
    for (int j = 0; j < 4; ++j) fg[j] = fgv[64 * j];
    for (int grp = gw; grp < MX / 8; grp += NGW) {
        const int row0 = grp * 8, b = row0 >> 11, t0 = row0 & (SEQ - 1);
        const f32x4* g2v = (const f32x4*)(mods + (size_t)b * NMOD + 5 * DM) + F.lane; f32x4 g2[4];
#pragma unroll
        for (int j = 0; j < 4; ++j) g2[j] = g2v[64 * j];
        const int sl0 = slot[(size_t)(b * NE + (F.lane & 15)) * SEQ + t0 + (F.lane >> 4)], sl1 = slot[(size_t)(b * NE + (F.lane & 15)) * SEQ + t0 + 4 + (F.lane >> 4)];
#pragma unroll 2
        for (int r = 0; r < 8; ++r) { const int row = row0 + r;
            const int sv = r < 4 ? sl0 : sl1;
            unsigned long long bal = __ballot(sv >= 0); unsigned mask = (unsigned)(bal >> (16 * (r & 3))) & 0xffffu;
            f32x4 acc[4];
#pragma unroll
            for (int j = 0; j < 4; ++j) acc[j] = (f32x4){0.f, 0.f, 0.f, 0.f};
            while (mask) {
                const v2u* yv[4]; float wgt[4];
#pragma unroll
                for (int i = 0; i < 4; ++i) { int e = 0, sidx = 0; wgt[i] = 0.f;
                    if (mask) { e = __builtin_ctz(mask); mask &= mask - 1; sidx = __builtin_amdgcn_readlane(sv, 16 * (r & 3) + e); wgt[i] = 1.f; }
                    yv[i] = (const v2u*)(YG + (size_t)((e * NB + b) * CAP + sidx) * DM) + F.lane; }
                v2u w[4][4];
#pragma unroll
                for (int i = 0; i < 4; ++i)
#pragma unroll
                    for (int j = 0; j < 4; ++j) w[i][j] = yv[i][64 * j];
#pragma unroll
                for (int i = 0; i < 4; ++i)
#pragma unroll
                    for (int j = 0; j < 4; ++j) acc[j] += (f32x4){bf_lo(w[i][j].x), bf_hi(w[i][j].x), bf_lo(w[i][j].y), bf_hi(w[i][j].y)} * wgt[i];
            }
            const f32x4* xin = (const f32x4*)(a.in[0] + (size_t)row * DM) + F.lane; const v2u* mv = (const v2u*)((const bf16_t*)(F.ws + WS_MIX) + (size_t)row * DM) + F.lane;
            f32x4* xv = (f32x4*)(a.out + (size_t)row * DM) + F.lane; f32x4 v[4]; float s = 0.f;
#pragma unroll
            for (int j = 0; j < 4; ++j) { const v2u mw = mv[64 * j]; v[j] = (xin[64 * j] + (f32x4){bf_lo(mw.x), bf_hi(mw.x), bf_lo(mw.y), bf_hi(mw.y)}) + g2[j] * acc[j]; s += (v[j].x * v[j].x + v[j].y * v[j].y) + (v[j].z * v[j].z + v[j].w * v[j].w); }
            const float rstd = __builtin_amdgcn_rsqf(wave_sum(s) * (1.f / DM) + EPS);
#pragma unroll
            for (int j = 0; j < 4; ++j) (DRY ? (f32x4*)((float*)(F.ws + WS_O1) + (size_t)row * DM) + F.lane : xv)[64 * j] = v[j] * rstd * fg[j];
        }
    }
}

__global__ void __launch_bounds__(NWAVES * 64, 2) mk_fwd(Args args) {
    extern __shared__ __attribute__((aligned(16))) unsigned char lds[];
    Frame F;
    F.lds = (LAS unsigned char*)lds;
    F.tid = threadIdx.x; F.lane = F.tid & 63; F.wave = __builtin_amdgcn_readfirstlane(F.tid >> 6);
    F.G = gridDim.x; { const int bx = blockIdx.x; F.vcu = (F.G % 8 == 0) ? (bx % 8) * (F.G / 8) + bx / 8 : bx; }
    F.ws = args.ws;
    volatile LAS unsigned* MISC = (volatile LAS unsigned*)(F.lds + MISC_OFF);
    gu32* ctl = (gu32*)(F.ws + WS_CTL);
    for (int u = F.tid; u < (LDS_BYTES - LDSCTL_OFF) / 4; u += NWAVES * 64) ((LAS unsigned*)(F.lds + LDSCTL_OFF))[u] = 0u;
    {
        LAS float* rope = (LAS float*)(F.lds + ROPE_OFF);
        for (int i = F.tid; i < 64 * 16; i += NWAVES * 64) { const int pos = i >> 4, f = i & 15;
            const float inv = __builtin_amdgcn_exp2f(-(float)f * (13.287712379549449f / 16.f)); const float ang = (float)pos * inv;
            rope[2 * i] = cosf(ang); rope[2 * i + 1] = sinf(ang); }
    }
    __syncthreads();
    const int lo = args.ph_lo, hi = args.ph_hi;
    XcdBarrier bar; bar.bar = (unsigned*)(ctl + CW_BAR) + args.li * XCD_BAR_WORDS; bar.x = 0; bar.st = nullptr;
    if (hi - lo > 1) bar = xcd_barrier_post((unsigned*)(ctl + CW_BAR) + args.li * XCD_BAR_WORDS, MISC + 8);
#ifndef MK_PHASES
#define MK_PHASES 0xfff
#endif
#define IN(k) ((((MK_PHASES) >> (k)) & 1) && lo <= (k) && (k) < hi)
#define SEAM(k) do { if (IN(k) && IN((k) + 1)) xcd_barrier(bar); } while (0)

    if (IN(0)) { p0_prologue(F, args); __syncthreads(); } SEAM(0);
    if (IN(1)) { p1_norm(F, args); } SEAM(1);
    if (IN(2)) {
        pg8::Gemm g{(const bf16_t*)(F.ws + WS_A1), (const bf16_t*)(F.ws + WS_WIN), DM}; pg8::OrdInProj S{F.G, (int)blockIdx.x};
        pg8::EpiInProj E{(bf16_t*)(F.ws + WS_Z), (bf16_t*)(F.ws + WS_GB), (bf16_t*)(F.ws + WS_Q), (bf16_t*)(F.ws + WS_KALL), (bf16_t*)(F.ws + WS_VALL), (bf16_t*)(F.ws + WS_S6), (bf16_t*)(F.ws + WS_S7),
                         (const LAS float*)(F.lds + ROPE_OFF)};
        pg8::gemm_phase<pg8::EpiInProj, pg8::OrdInProj, true, true>(F.lds, g, S, E);
        if (F.G == 256 && blockIdx.x >= 64) {
            LAS float* scr = (LAS float*)(F.lds + F.wave * FP8_SCR_STRIDE); const int w0 = ((int)blockIdx.x - 64) * NWAVES * WD_EARLY_PER_WAVE + F.wave;
            for (int w = w0; w < w0 + NWAVES * WD_EARLY_PER_WAVE; w += NWAVES) wd_item(F, args, w, scr);
        }
    } SEAM(2);
    if (IN(3)) { if (!(F.vcu & 1)) { p3_conv(F, args); p3_weight_share(F, args); __syncthreads(); } p3_attn<-1>(F, args, (char*)lds); if (F.vcu & 1) { __syncthreads(); p3_conv(F, args); p3_weight_share(F, args); } __syncthreads(); } SEAM(3);
    if (IN(4)) {
        constexpr size_t TB = (size_t)256 * DM * 2;
        static_assert(WS_A1 % TB == 0 && WS_OATT % TB == 0 && WS_WC % TB == 0 && WS_WO % TB == 0, "virtual tile indices need tile-aligned buffers");
        pg8::OrdMerge S; S.base.init(MX / 256, DM / 256, F.G, (int)blockIdx.x); S.pmA0 = (int)(WS_A1 / TB); S.pmA1 = (int)(WS_OATT / TB); S.pbB0 = (int)(WS_WC / TB); S.pbB1 = (int)(WS_WO / TB);
        pg8::Gemm g{(const bf16_t*)F.ws, (const bf16_t*)F.ws, DM};
        pg8::EpiMerge E{(const bf16_t*)(F.ws + WS_S6), (const bf16_t*)(F.ws + WS_S7), (bf16_t*)(F.ws + WS_MERGED)};
        pg8::gemm_phase<pg8::EpiMerge, pg8::OrdMerge, true, true>(F.lds, g, S, E);
    } SEAM(4);
    if (IN(5)) {
        pg8::OrdGrid S; S.init(MX / 256, DM / 256, F.G, (int)blockIdx.x);
        pg8::Gemm g{(const bf16_t*)(F.ws + WS_MERGED), (const bf16_t*)(F.ws + WS_WOUT), DM}; pg8::EpiOut E{(const float*)(F.ws + WS_MODS), (bf16_t*)(F.ws + WS_MIX)};
        pg8::gemm_phase<pg8::EpiOut, pg8::OrdGrid, false, true>(F.lds, g, S, E);
    } SEAM(5);
    if (IN(6)) { p6_norm_router(F, args); } SEAM(6);
    if (IN(7)) { p7_topk_weights(F, args); __syncthreads(); } SEAM(7);
    if (IN(8)) {
        LAS unsigned* gtab = (LAS unsigned*)(F.lds + GTAB_OFF); const int* gidx = (const int*)(F.ws + WS_GIDX);
        for (int i0 = 0; (long)i0 * F.G < 2048; i0 += 8) {
            pg8::OrdMoe<16> S{F.G, (int)blockIdx.x, i0, 8};
            for (int i = 0; i < 8; ++i) { pg8::Unit u; if (!S.next(i, u)) break; if (F.tid < 256) gtab[i * 256 + F.tid] = (unsigned)gidx[u.pm * 256 + F.tid] * (unsigned)DM; }
            __syncthreads();
            pg8::Gemm g{(const bf16_t*)(F.ws + WS_HX2), (const bf16_t*)(F.ws + WS_WGU), DM / 2}; pg8::EpiSwiGLU E{(unsigned char*)(F.ws + WS_H)};
            pg8::gemm_phase<pg8::EpiSwiGLU, pg8::OrdMoe<16>, true, true, true, true>(F.lds, g, S, E, (const LAS unsigned*)gtab);
            __syncthreads();
        }
    } SEAM(8);
    if (IN(9)) {
        pg8::Gemm g{(const bf16_t*)(F.ws + WS_H), (const bf16_t*)(F.ws + WS_WD), FH / 2}; pg8::OrdMoe<4> S{F.G, (int)blockIdx.x, 0, 1 << 30}; pg8::EpiDown E{(const float*)(F.ws + WS_GATE), (bf16_t*)(F.ws + WS_YG)};
        pg8::gemm_phase<pg8::EpiDown, pg8::OrdMoe<4>, true, true, false, true>(F.lds, g, S, E);
    } SEAM(9);
    if (IN(10)) { p10_final<false>(F, args); }
    if (IN(11)) { p10_final<true>(F, args); }
#undef IN
#undef SEAM
}

#if MK_ATTN_PROBE >= 0
__global__ void __launch_bounds__(NWAVES * 64, 2) mk_attn_probe(Args args) {
    extern __shared__ __attribute__((aligned(16))) unsigned char lds[];
    Frame F; F.lds = (LAS unsigned char*)lds; F.tid = threadIdx.x; F.lane = F.tid & 63; F.wave = __builtin_amdgcn_readfirstlane(F.tid >> 6);
    F.G = gridDim.x; { const int bx = blockIdx.x; F.vcu = (F.G % 8 == 0) ? (bx % 8) * (F.G / 8) + bx / 8 : bx; } F.ws = args.ws;
    p3_attn<MK_ATTN_PROBE>(F, args, (char*)lds);
}
#endif
extern "C" void kernel_launch(void* const* d_in, const int* in_sizes, int n_in, void* d_out, int out_size, void* d_ws, size_t ws_size, hipStream_t stream) {
    static int grid = 0;
    if (grid == 0) {
        if (n_in != 23 || in_sizes[0] != MX * DM || out_size != MX * DM || ws_size < WS_END) {
            fprintf(stderr, "kernel_launch: unexpected shapes: n_in %d in0 %d out %d ws %zu (need %zu)\n", n_in, n_in > 0 ? in_sizes[0] : -1, out_size, ws_size, (size_t)WS_END); grid = -1; return; }
        int dev = 0, cus = 0;
        if (hipGetDevice(&dev) != hipSuccess || hipDeviceGetAttribute(&cus, hipDeviceAttributeMultiprocessorCount, dev) != hipSuccess) { grid = -1; return; }
        if (hipFuncSetAttribute((const void*)mk_fwd, hipFuncAttributeMaxDynamicSharedMemorySize, LDS_BYTES) != hipSuccess) { fprintf(stderr, "kernel_launch: hipFuncSetAttribute failed\n"); grid = -1; return; }
        int per_cu = 0;
        if (hipOccupancyMaxActiveBlocksPerMultiprocessor(&per_cu, (const void*)mk_fwd, NWAVES * 64, LDS_BYTES) != hipSuccess || per_cu < 1) fprintf(stderr, "kernel_launch: occupancy query reports %d\n", per_cu);
        (void)hipGetLastError();
        grid = cus;
    }
    if (grid < 0) return;
    if (hipMemsetAsync((char*)d_ws + WS_CTL, 0, CTL_ZERO_BYTES, stream) != hipSuccess) return;
    Args a{};
    for (int i = 0; i < 23; ++i) a.in[i] = (const float*)d_in[i];
    a.out = (float*)d_out; a.ws = (unsigned char*)d_ws;
#if MK_ATTN_PROBE >= 0
    (void)hipFuncSetAttribute((const void*)mk_attn_probe, hipFuncAttributeMaxDynamicSharedMemorySize, LDS_BYTES);
    a.ph_lo = 0; a.ph_hi = 4; a.li = 0; hipLaunchKernelGGL(mk_fwd, dim3(grid), dim3(NWAVES * 64), LDS_BYTES, stream, a);
    hipLaunchKernelGGL(mk_attn_probe, dim3(grid), dim3(NWAVES * 64), LDS_BYTES, stream, a);
    a.ph_lo = 4; a.ph_hi = N_PHASES; a.li = 1; hipLaunchKernelGGL(mk_fwd, dim3(grid), dim3(NWAVES * 64), LDS_BYTES, stream, a);
    return;
#endif
#ifdef MK_P10_PROBE
    a.ph_lo = 0; a.ph_hi = 10; a.li = 0; hipLaunchKernelGGL(mk_fwd, dim3(grid), dim3(NWAVES * 64), LDS_BYTES, stream, a);
    a.ph_lo = 11; a.ph_hi = 12; a.li = 1; hipLaunchKernelGGL(mk_fwd, dim3(grid), dim3(NWAVES * 64), LDS_BYTES, stream, a);
    a.ph_lo = 10; a.ph_hi = 11; a.li = 1; hipLaunchKernelGGL(mk_fwd, dim3(grid), dim3(NWAVES * 64), LDS_BYTES, stream, a);
    return;
#endif
    if (MK_PROBE_LO >= 0) {
        a.ph_lo = 0; a.ph_hi = MK_PROBE_HI; a.li = 0; hipLaunchKernelGGL(mk_fwd, dim3(grid), dim3(NWAVES * 64), LDS_BYTES, stream, a);
        a.ph_lo = MK_PROBE_LO; a.ph_hi = N_PHASES; a.li = 1; hipLaunchKernelGGL(mk_fwd, dim3(grid), dim3(NWAVES * 64), LDS_BYTES, stream, a);
        return;
    }
    for (int li = 0; li < N_LAUNCHES; ++li) {
        a.ph_lo = (N_LAUNCHES == 1) ? 0 : li; a.ph_hi = (N_LAUNCHES == 1) ? N_PHASES : li + 1; a.li = (N_LAUNCHES == 1) ? 0 : 0;
        hipLaunchKernelGGL(mk_fwd, dim3(grid), dim3(NWAVES * 64), LDS_BYTES, stream, a);
    }
}
```
